# Optimizing an MI355X kernel written in HIP

```python
import jax, jax.numpy as jnp
from jax import lax
import numpy as np

D_MODEL = 1024
BATCH = 8
SEQ = 2048
DEPTH = 2
DEC_BATCH = 128
DEC_SEQ = 1
PAST_LEN = 16384
PAGE_SIZE = 128

N_A_LAYERS = (DEPTH + 1) // 2
N_C_LAYERS = DEPTH // 2

A_HEADS = 4
A_DK = 128
A_DV = 128
A_KW = A_HEADS * A_DK
A_WIDTH = A_HEADS * A_DV
A_CHUNK = 32
B_WIDTH = D_MODEL - A_WIDTH
SC_WIDTH = 3
EVEN_SPLITS = (A_KW, 2 * A_KW, 2 * A_KW + A_WIDTH, 2 * A_KW + 2 * A_WIDTH,
               2 * A_KW + 2 * A_WIDTH + B_WIDTH, 2 * A_KW + 2 * A_WIDTH + 2 * B_WIDTH)
IN_EVEN = 2 * A_KW + 2 * A_WIDTH + 3 * B_WIDTH

M_INNER = 2 * D_MODEL
M_HEADDIM = 64
M_HEADS = M_INNER // M_HEADDIM
M_STATE = 128
M_GROUPS = 4
M_HPG = M_HEADS // M_GROUPS
M_CONV = 4
M_CHUNK = 64
M_GN = M_GROUPS * M_STATE
M_CONV_DIM = M_INNER + 2 * M_GN
IN_ODD = M_INNER + M_CONV_DIM + M_HEADS

D_FF = 4 * D_MODEL
EPS = 1e-6

kernel_name = 'hybrid_hgrn2_shortconv_ssd_step'


def rmsnorm(x, g):
    xf = x.astype(jnp.float32)
    y = xf * lax.rsqrt(jnp.mean(xf * xf, axis=-1, keepdims=True) + EPS)
    return (y * g.astype(jnp.float32)).astype(x.dtype)


def causal_dwconv(u, buf, w):
    full = jnp.concatenate([buf.astype(u.dtype), u], axis=1)
    T = u.shape[1]
    W = w.shape[0]
    out = sum(full[:, k:k + T] * w[k] for k in range(W))
    return out, full[:, full.shape[1] - (W - 1):]


def gla_chunked(q, k, v, logf, chunk):
    Bn, T, H, K = q.shape
    V = v.shape[-1]
    n = T // chunk
    r = lambda a: a.reshape(Bn, n, chunk, H, a.shape[-1]).astype(jnp.float32)
    q, k, v, logf = r(q), r(k), r(v), r(logf)
    b = jnp.cumsum(logf, axis=2)
    b_last = b[:, :, -1:]
    qd = q * jnp.exp(b)
    kd = k * jnp.exp(-b)
    mask = jnp.tril(jnp.ones((chunk, chunk), bool))
    att = jnp.where(mask, jnp.einsum('bnihk,bnjhk->bnhij', qd, kd), 0.0)
    o_intra = jnp.einsum('bnhij,bnjhv->bnihv', att, v)
    dS = jnp.einsum('bnjhk,bnjhv->bnhkv', k * jnp.exp(b_last - b), v)
    decay = jnp.exp(b_last[:, :, 0])

    def step(S, inp):
        d, ds = inp
        return d[..., None] * S + ds, S

    S_fin, S_in = lax.scan(step, jnp.zeros((Bn, H, K, V), jnp.float32),
                           (jnp.moveaxis(decay, 1, 0), jnp.moveaxis(dS, 1, 0)))
    S_in = jnp.moveaxis(S_in, 0, 1)
    o_inter = jnp.einsum('bnihk,bnhkv->bnihv', qd, S_in)
    return (o_intra + o_inter).reshape(Bn, T, H, V), S_fin


def gla_recurrent(q, k, v, logf, S0):
    def step(S, inp):
        qt, kt, vt, lft = inp
        S = jnp.exp(lft)[..., None] * S + kt[..., None] * vt[..., None, :]
        return S, jnp.einsum('bhk,bhkv->bhv', qt, S)

    xs = tuple(jnp.moveaxis(a.astype(jnp.float32), 1, 0) for a in (q, k, v, logf))
    S, o = lax.scan(step, S0.astype(jnp.float32), xs)
    return jnp.moveaxis(o, 0, 1), S


def ssd_chunked(x, dt, A, Bm, Cm, chunk):
    Bn, T, G, R, P = x.shape
    N = Bm.shape[-1]
    n = T // chunk
    x = x.reshape(Bn, n, chunk, G, R, P)
    dt = dt.reshape(Bn, n, chunk, G, R)
    Bm = Bm.reshape(Bn, n, chunk, G, N)
    Cm = Cm.reshape(Bn, n, chunk, G, N)
    cs = jnp.cumsum(dt * A, axis=2)
    seg = cs[:, :, :, None] - cs[:, :, None, :]
    mask = jnp.tril(jnp.ones((chunk, chunk), bool))[:, :, None, None]
    decay_ij = jnp.exp(jnp.where(mask, seg, -jnp.inf))
    cb = jnp.einsum('bnigs,bnjgs->bnijg', Cm, Bm)
    wts = cb[..., None] * decay_ij * dt[:, :, None]
    y_diag = jnp.einsum('bnijgr,bnjgrp->bnigrp', wts, x)
    cs_last = cs[:, :, -1:]
    xw = x * (jnp.exp(cs_last - cs) * dt)[..., None]
    dS = jnp.einsum('bnjgs,bnjgrp->bngrps', Bm, xw)
    chunk_decay = jnp.exp(cs_last[:, :, 0])

    def step(S, inp):
        d, ds = inp
        return d[..., None, None] * S + ds, S

    S_fin, S_in = lax.scan(step, jnp.zeros((Bn, G, R, P, N), jnp.float32),
                           (jnp.moveaxis(chunk_decay, 1, 0), jnp.moveaxis(dS, 1, 0)))
    S_in = jnp.moveaxis(S_in, 0, 1)
    y_off = jnp.einsum('bnigs,bngrps->bnigrp', Cm, S_in) * jnp.exp(cs)[..., None]
    return (y_diag + y_off).reshape(Bn, T, G, R, P), S_fin


def ssd_recurrent(x, dt, A, Bm, Cm, S0):
    def step(S, inp):
        xt, dtt, Bt, Ct = inp
        S = (jnp.exp(dtt * A)[..., None, None] * S
             + (dtt[..., None] * xt)[..., None] * Bt[:, :, None, None, :])
        return S, jnp.einsum('bgs,bgrps->bgrp', Ct, S)

    xs = tuple(jnp.moveaxis(a, 1, 0) for a in (x, dt, Bm, Cm))
    S, y = lax.scan(step, S0, xs)
    return jnp.moveaxis(y, 0, 1), S


def even_mixer(h, sc_buf, hgrn_state, w_in, lb, gnorm_w, sc_w, w_out, prompt):
    Bn, T, _ = h.shape
    proj = h @ w_in
    q, fz, iv, go, bg, cg, hv = jnp.split(proj, EVEN_SPLITS, axis=-1)
    f = lb + (1.0 - lb) * jax.nn.sigmoid(fz.astype(jnp.float32))
    hs = lambda a, d: a.reshape(Bn, T, A_HEADS, d)
    qh = hs(q.astype(jnp.float32), A_DK)
    kh = hs(1.0 - f, A_DK)
    lf = hs(jnp.log(f), A_DK)
    vh = hs(iv.astype(jnp.float32), A_DV)
    if prompt:
        o, S = gla_chunked(qh, kh, vh, lf, A_CHUNK)
    else:
        o, S = gla_recurrent(qh, kh, vh, lf, hgrn_state)
    o = rmsnorm(o, gnorm_w) * jax.nn.silu(hs(go.astype(jnp.float32), A_DV))
    o_a = o.reshape(Bn, T, A_WIDTH).astype(h.dtype)
    if sc_buf is None:
        sc_buf = jnp.zeros((Bn, SC_WIDTH - 1, B_WIDTH), h.dtype)
    conv, new_sc = causal_dwconv(cg * hv, sc_buf, sc_w)
    o_b = bg * conv
    out = jnp.concatenate([o_a, o_b], axis=-1) @ w_out
    return out, S, new_sc


def mamba_mixer(h, conv_buf, ssm_state, w_in, conv_w, conv_b, dt_bias, a_log, d_skip, norm_w, w_out, prompt):
    Bn, T, _ = h.shape
    z, xbc, dt_raw = jnp.split(h @ w_in, (M_INNER, M_INNER + M_CONV_DIM), axis=-1)
    if conv_buf is None:
        conv_buf = jnp.zeros((Bn, M_CONV - 1, M_CONV_DIM), h.dtype)
    xbc, new_buf = causal_dwconv(xbc, conv_buf, conv_w)
    xbc = jax.nn.silu(xbc + conv_b)
    xs, Bm, Cm = jnp.split(xbc.astype(jnp.float32), (M_INNER, M_INNER + M_GN), axis=-1)
    xs = xs.reshape(Bn, T, M_GROUPS, M_HPG, M_HEADDIM)
    Bm = Bm.reshape(Bn, T, M_GROUPS, M_STATE)
    Cm = Cm.reshape(Bn, T, M_GROUPS, M_STATE)
    dt = jax.nn.softplus(dt_raw.astype(jnp.float32) + dt_bias.astype(jnp.float32))
    dt = dt.reshape(Bn, T, M_GROUPS, M_HPG)
    A = -jnp.exp(a_log.astype(jnp.float32)).reshape(M_GROUPS, M_HPG)
    if prompt:
        y, S = ssd_chunked(xs, dt, A, Bm, Cm, M_CHUNK)
    else:
        S0 = ssm_state.astype(jnp.float32).reshape(Bn, M_GROUPS, M_HPG, M_HEADDIM, M_STATE)
        y, S = ssd_recurrent(xs, dt, A, Bm, Cm, S0)
    y = y + d_skip.astype(jnp.float32).reshape(M_GROUPS, M_HPG)[..., None] * xs
    y = y.reshape(Bn, T, M_INNER) * jax.nn.silu(z.astype(jnp.float32))
    y = rmsnorm(y.reshape(Bn, T, M_GROUPS, M_INNER // M_GROUPS),
                norm_w.reshape(M_GROUPS, M_INNER // M_GROUPS)).reshape(Bn, T, M_INNER)
    out = y.astype(h.dtype) @ w_out
    return out, S.reshape(Bn, M_HEADS, M_HEADDIM, M_STATE), new_buf


def trunk(x, c, st_hgrn, st_sc, st_ssm, st_mconv, params, prompt):
    (ada_w, ada_b, norm_mix, norm_mlp, norm_final, w_in_even, hgrn_lb, hgrn_gnorm, sc_w, w_out_even,
     w_in_odd, mconv_w, mconv_b, dt_bias, a_log, d_skip, m_norm, w_out_odd, mlp_w1, mlp_w2) = params
    p_lb = jax.nn.softmax(hgrn_lb.astype(jnp.float32), axis=0)
    lbs = jnp.cumsum(p_lb, axis=0) - p_lb[0]
    hg_l, sc_l, ssm_l, mc_l = [], [], [], []
    for l in range(DEPTH):
        j = l // 2
        mod = jax.nn.silu(c) @ ada_w[l] + ada_b[l]
        sh1, s1, g1, sh2, s2, g2 = jnp.split(mod[:, None, :], 6, axis=-1)
        h = rmsnorm(x, norm_mix[l]) * (1.0 + s1) + sh1
        if l % 2 == 0:
            out, S, buf = even_mixer(h, None if prompt else st_sc[j], None if prompt else st_hgrn[j],
                                     w_in_even[j], lbs[j + 1], hgrn_gnorm[j], sc_w[j], w_out_even[j], prompt)
            hg_l.append(S.astype(x.dtype))
            sc_l.append(buf.astype(x.dtype))
        else:
            out, S, buf = mamba_mixer(h, None if prompt else st_mconv[j], None if prompt else st_ssm[j],
                                      w_in_odd[j], mconv_w[j], mconv_b[j], dt_bias[j], a_log[j], d_skip[j],
                                      m_norm[j], w_out_odd[j], prompt)
            ssm_l.append(S.astype(x.dtype))
            mc_l.append(buf.astype(x.dtype))
        x = x + g1 * out
        h = rmsnorm(x, norm_mlp[l]) * (1.0 + s2) + sh2
        x = x + g2 * (jnp.square(jax.nn.relu(h @ mlp_w1[l])) @ mlp_w2[l])
    y = rmsnorm(x, norm_final)
    return y, jnp.stack(hg_l), jnp.stack(sc_l), jnp.stack(ssm_l), jnp.stack(mc_l)


def setup_inputs(seed: int = 0) -> dict:
    key = jax.random.key(seed)
    ks = jax.random.split(key, 32)
    nrm = lambda k, shape, s: jax.random.normal(k, shape, jnp.float32) * s
    dt0 = jnp.exp(jax.random.uniform(ks[20], (N_C_LAYERS, M_HEADS), jnp.float32)
                  * (np.log(0.1) - np.log(0.001)) + np.log(0.001))
    return {
        'x_prompt': nrm(ks[0], (BATCH, SEQ, D_MODEL), 1.0),
        'x_sample': nrm(ks[1], (DEC_BATCH, DEC_SEQ, D_MODEL), 1.0),
        'c_prompt': nrm(ks[2], (BATCH, D_MODEL), 1.0),
        'c_sample': nrm(ks[3], (DEC_BATCH, D_MODEL), 1.0),
        'state_hgrn': nrm(ks[4], (N_A_LAYERS, DEC_BATCH, A_HEADS, A_DK, A_DV), 0.3),
        'state_shortconv': nrm(ks[5], (N_A_LAYERS, DEC_BATCH, SC_WIDTH - 1, B_WIDTH), 1.0),
        'state_ssm': nrm(ks[6], (N_C_LAYERS, DEC_BATCH, M_HEADS, M_HEADDIM, M_STATE), 0.3),
        'state_mconv': nrm(ks[7], (N_C_LAYERS, DEC_BATCH, M_CONV - 1, M_CONV_DIM), 1.0),
        'ada_w': nrm(ks[8], (DEPTH, D_MODEL, 6 * D_MODEL), 0.5 * D_MODEL ** -0.5),
        'ada_b': nrm(ks[9], (DEPTH, 6 * D_MODEL), 0.02),
        'norm_mix': 1.0 + nrm(ks[10], (DEPTH, D_MODEL), 0.02),
        'norm_mlp': 1.0 + nrm(ks[11], (DEPTH, D_MODEL), 0.02),
        'norm_final': 1.0 + nrm(ks[12], (D_MODEL,), 0.02),
        'w_in_even': nrm(ks[13], (N_A_LAYERS, D_MODEL, IN_EVEN), D_MODEL ** -0.5),
        'hgrn_lb': nrm(ks[14], (N_A_LAYERS + 1, A_KW), 0.1),
        'hgrn_gnorm': 1.0 + nrm(ks[15], (N_A_LAYERS, A_DV), 0.02),
        'sc_w': nrm(ks[16], (N_A_LAYERS, SC_WIDTH, B_WIDTH), SC_WIDTH ** -0.5),
        'w_out_even': nrm(ks[17], (N_A_LAYERS, D_MODEL, D_MODEL), D_MODEL ** -0.5),
        'w_in_odd': nrm(ks[18], (N_C_LAYERS, D_MODEL, IN_ODD), D_MODEL ** -0.5),
        'mconv_w': nrm(ks[19], (N_C_LAYERS, M_CONV, M_CONV_DIM), M_CONV ** -0.5),
        'mconv_b': nrm(ks[21], (N_C_LAYERS, M_CONV_DIM), 0.02),
        'dt_bias': dt0 + jnp.log(-jnp.expm1(-dt0)),
        'a_log': jnp.log(jax.random.uniform(ks[22], (N_C_LAYERS, M_HEADS), jnp.float32, 1.0, 16.0)),
        'd_skip': 1.0 + nrm(ks[23], (N_C_LAYERS, M_HEADS), 0.1),
        'm_norm': 1.0 + nrm(ks[24], (N_C_LAYERS, M_INNER), 0.02),
        'w_out_odd': nrm(ks[25], (N_C_LAYERS, M_INNER, D_MODEL), M_INNER ** -0.5),
        'mlp_w1': nrm(ks[26], (DEPTH, D_MODEL, D_FF), D_MODEL ** -0.5),
        'mlp_w2': nrm(ks[27], (DEPTH, D_FF, D_MODEL), D_FF ** -0.5),
    }


def reference(x_prompt, x_sample, c_prompt, c_sample, state_hgrn, state_shortconv, state_ssm, state_mconv,
              ada_w, ada_b, norm_mix, norm_mlp, norm_final, w_in_even, hgrn_lb, hgrn_gnorm, sc_w, w_out_even,
              w_in_odd, mconv_w, mconv_b, dt_bias, a_log, d_skip, m_norm, w_out_odd, mlp_w1, mlp_w2):
    params = (ada_w, ada_b, norm_mix, norm_mlp, norm_final, w_in_even, hgrn_lb, hgrn_gnorm, sc_w, w_out_even,
              w_in_odd, mconv_w, mconv_b, dt_bias, a_log, d_skip, m_norm, w_out_odd, mlp_w1, mlp_w2)
    y_prompt, hg_p, sc_p, ssm_p, mc_p = trunk(x_prompt, c_prompt, None, None, None, None, params, True)
    y_sample, hg_s, sc_s, ssm_s, mc_s = trunk(x_sample, c_sample, state_hgrn, state_shortconv,
                                              state_ssm, state_mconv, params, False)
    return (y_prompt, y_sample, hg_p, hg_s, sc_p, sc_s, ssm_p, ssm_s, mc_p, mc_s)
```

```cpp
#include <hip/hip_runtime.h>
#include <cstdio>
#include <cstdint>
namespace pg8 {
#define PG8_LAS __attribute__((address_space(3)))
typedef unsigned short bf16_t;
typedef short bf16x8 __attribute__((ext_vector_type(8)));
typedef float f32x4 __attribute__((ext_vector_type(4)));
typedef unsigned u32x4 __attribute__((ext_vector_type(4)));
constexpr int BM = 256, BK = 64, HALF = 128, HTB = HALF * BK * 2  , STAGE_BYTES = 8 * HTB, NXCD = 8, WGM = 8;

__host__ __device__ __forceinline__ int lds_byte(int r, int c) { const int st = (r >> 4) * 2 + (c >> 5), rr = r & 15, cc = c & 31, ob = rr * 64 + cc * 2; return st * 1024 + (ob ^ (((ob >> 9) & 1) << 5)); }
__host__ __device__ __forceinline__ void stage_rc(int b, int& R, int& C) { const int st = b / 1024, sb = b % 1024, swz = sb ^ (((sb >> 9) & 1) << 5); R = (st >> 1) * 16 + swz / 64; C = (st & 1) * 32 + (swz % 64) / 2; }
__host__ __device__ __forceinline__ int perm32(int rho) { const int n = rho >> 4, i = rho & 15; return 8 * (i >> 2) + 4 * n + (i & 3); }

struct Unit { int pm, pn; };
struct Gemm { const bf16_t* A; const bf16_t* Bt; int M, N, K; };

struct StaticOrder {
    int nM, nN, nwg, G, c;
    __host__ __device__ void init(int M, int N, int G_, int c_) { nM = M / BM; nN = N / BM; nwg = nM * nN; G = G_; c = c_; }
    __host__ __device__ bool next(int i, Unit& u) const {
        const long L = (long)i * G + c; if (L >= nwg) return false;
        int wgid = (int)L; { const int q = nwg / NXCD, r = nwg % NXCD, xcd = wgid % NXCD, off = wgid / NXCD; wgid = (xcd < r ? xcd * (q + 1) : r * (q + 1) + (xcd - r) * q) + off; }
        const int nig = WGM * nN, gid = wgid / nig, fm = gid * WGM, gsz = (nM - fm) < WGM ? (nM - fm) : WGM;
        u.pm = fm + ((wgid % nig) % gsz); u.pn = (wgid % nig) / gsz; return true;
    }
    __device__ __forceinline__ void a_ready(const Unit&) const {}
    __device__ __forceinline__ void done(const Unit&) const {}
};

__device__ __forceinline__ unsigned cvt_pk_bf16(float lo, float hi) { unsigned r; asm volatile("v_cvt_pk_bf16_f32 %0, %1, %2" : "=v"(r) : "v"(lo), "v"(hi)); return r; }

constexpr int ROWS_P = 16384, ROWS_T = 16512;
__device__ __forceinline__ int mod_row(int row) { return row < ROWS_P ? (row >> 11) : (row - ROWS_P + 8); }

template <int ACT> struct EpiBf16 {
    static constexpr bool PERM = true, AFTER_DRAIN = false;
    bf16_t* O; int ldc; const float* rs; const float* cb; int ldcb;
    __device__ __forceinline__ void operator()(const f32x4 (&acc)[2][2][4][2], const Unit& u, int wr, int wc, int fr, int fq) const {
        const int row0 = u.pm * BM + wr * 64 + fr; const int col0 = u.pn * BM + wc * 32 + 8 * fq;
        const float* cbr = cb + (size_t)(u.pm >> 3) * ldcb + col0;
        f32x4 cv[2][2];
#pragma unroll
        for (int bj = 0; bj < 2; ++bj) { cv[bj][0] = *(const f32x4*)(cbr + bj * HALF); cv[bj][1] = *(const f32x4*)(cbr + bj * HALF + 4); }
#pragma unroll
        for (int ai = 0; ai < 2; ++ai)
#pragma unroll
            for (int m = 0; m < 4; ++m) { const int row = row0 + ai * HALF + m * 16; bf16_t* rowp = O + (size_t)row * ldc + col0;
                const float rstd = __builtin_amdgcn_rsqf(rs[row] * (1.0f / 1024.0f) + 1e-6f);
#pragma unroll
                for (int bj = 0; bj < 2; ++bj) { f32x4 v0 = acc[ai][bj][m][0] * rstd + cv[bj][0], v1 = acc[ai][bj][m][1] * rstd + cv[bj][1];
                    if (ACT == 1) {
#pragma unroll
                        for (int e = 0; e < 4; ++e) { const float a = fmaxf(v0[e], 0.f), b = fmaxf(v1[e], 0.f); v0[e] = a * a; v1[e] = b * b; } }
                    u32x4 w; w.x = cvt_pk_bf16(v0[0], v0[1]); w.y = cvt_pk_bf16(v0[2], v0[3]); w.z = cvt_pk_bf16(v1[0], v1[1]); w.w = cvt_pk_bf16(v1[2], v1[3]);
                    *(u32x4*)(rowp + bj * HALF) = w; } }
    }
};

template <bool XIN_F32> struct EpiRes {
    static constexpr bool PERM = false, AFTER_DRAIN = false;
    const void* xin; bf16_t* out; const float* gate;
    bf16_t* xg; const float* gnw; const float* smod; float* rs_out;
    __device__ __forceinline__ void operator()(const f32x4 (&acc)[2][2][4][2], const Unit& u, int wr, int wc, int fr, int fq) const {
        typedef unsigned u32x2v __attribute__((ext_vector_type(2)));
        const int col0 = u.pn * BM + wc * 32 + 4 * fq; const int b = u.pm >> 3;
        const float* gr = gate + (size_t)b * 6144;
        f32x4 g4[2][2], gm[2][2];
#pragma unroll
        for (int bj = 0; bj < 2; ++bj)
#pragma unroll
            for (int n = 0; n < 2; ++n) { const int c = col0 + bj * HALF + n * 16; g4[bj][n] = *(const f32x4*)(gr + c);
                if (xg) gm[bj][n] = *(const f32x4*)(gnw + c) * (*(const f32x4*)(smod + (size_t)b * 6144 + c) + 1.0f); }
#pragma unroll
        for (int ai = 0; ai < 2; ++ai)
#pragma unroll
            for (int m = 0; m < 4; ++m) { const int row = u.pm * BM + ai * HALF + wr * 64 + m * 16 + fr; float ss = 0.f;
#pragma unroll
                for (int bj = 0; bj < 2; ++bj)
#pragma unroll
                    for (int n = 0; n < 2; ++n) { const int c = col0 + bj * HALF + n * 16; f32x4 x4;
                        if (XIN_F32) x4 = *(const f32x4*)((const float*)xin + (size_t)row * 1024 + c);
                        else { const u32x2v xb = *(const u32x2v*)((const bf16_t*)xin + (size_t)row * 1024 + c);
                            x4 = (f32x4){__builtin_bit_cast(float, xb.x << 16), __builtin_bit_cast(float, xb.x & 0xffff0000u), __builtin_bit_cast(float, xb.y << 16), __builtin_bit_cast(float, xb.y & 0xffff0000u)}; }
                        const f32x4 o4 = x4 + g4[bj][n] * acc[ai][bj][m][n];
                        u32x2v ow; ow.x = cvt_pk_bf16(o4[0], o4[1]); ow.y = cvt_pk_bf16(o4[2], o4[3]); *(u32x2v*)(out + (size_t)row * 1024 + c) = ow;
                        if (xg) { ss += (o4[0] * o4[0] + o4[1] * o4[1]) + (o4[2] * o4[2] + o4[3] * o4[3]); const f32x4 y = o4 * gm[bj][n];
                            u32x2v w; w.x = cvt_pk_bf16(y[0], y[1]); w.y = cvt_pk_bf16(y[2], y[3]); *(u32x2v*)(xg + (size_t)row * 1024 + c) = w; } }
                if (xg) { ss += __shfl_xor(ss, 16); ss += __shfl_xor(ss, 32); if (fq == 0) (void)__hip_atomic_fetch_add(rs_out + row, ss, __ATOMIC_RELAXED, __HIP_MEMORY_SCOPE_AGENT); } }
    }
};

template <class Epi, class Sched, bool ALIGN_EPI = false, bool SP2 = false>
__device__ __forceinline__ void gemm_phase(PG8_LAS unsigned char* lds, const Gemm g, const Sched& S, const Epi& E) {
    const int tid = threadIdx.x, wid = __builtin_amdgcn_readfirstlane(tid >> 6), lane = tid & 63, wr = wid >> 2, wc = wid & 3, fr = lane & 15, fq = lane >> 4;
    const int K = g.K, nt = K / BK;
    unsigned voffA[2], voffB[2];
#pragma unroll
    for (int i = 0; i < 2; ++i) { int R, C; stage_rc(tid * 16 + i * 8192, R, C); const int Rb = Epi::PERM ? ((R & ~31) + perm32(R & 31)) : R;
        voffA[i] = (unsigned)(R * K + C) * 2u; voffB[i] = (unsigned)(Rb * K + C) * 2u; }
    const size_t kstep = (size_t)(BK * 2);
    const size_t hstep = (size_t)HALF * K * 2;
    const size_t tstep = 2 * hstep;
    const unsigned ldsw = (unsigned)wid * 1024u;
    const int aoff = lds_byte(wr * 64 + fr, fq * 8), boff = lds_byte(wc * 32 + fr, fq * 8);
#define PG8_SA(b, h) (((b) * 2 + (h)) * HTB)
#define PG8_SB(b, h) ((4 + (b) * 2 + (h)) * HTB)
#define PG8_STAGE(bufoff, gbase, voff) do { _Pragma("unroll") for (int _i = 0; _i < 2; ++_i) \
        __builtin_amdgcn_global_load_lds((const unsigned*)((const char*)(gbase) + (voff)[_i]), (PG8_LAS unsigned*)(lds + (bufoff) + ldsw + _i * 8192), 16, 0, 0); } while (0)
#define PG8_LDA(dst, b, h) do { _Pragma("unroll") for (int m = 0; m < 4; ++m) _Pragma("unroll") for (int k = 0; k < 2; ++k) dst[m][k] = *(const PG8_LAS bf16x8*)(lds + PG8_SA(b, h) + aoff + m * 2048 + k * 1024); } while (0)
#define PG8_LDB(dst, b, h) do { _Pragma("unroll") for (int n = 0; n < 2; ++n) _Pragma("unroll") for (int k = 0; k < 2; ++k) dst[n][k] = *(const PG8_LAS bf16x8*)(lds + PG8_SB(b, h) + boff + n * 2048 + k * 1024); } while (0)
#define PG8_MMA(ai, bj, At, Bt) do { __builtin_amdgcn_s_setprio(1); _Pragma("unroll") for (int m = 0; m < 4; ++m) _Pragma("unroll") for (int n = 0; n < 2; ++n) _Pragma("unroll") for (int k = 0; k < 2; ++k) \
        acc[ai][bj][m][n] = __builtin_amdgcn_mfma_f32_16x16x32_bf16(Bt[n][k], At[m][k], acc[ai][bj][m][n], 0, 0, 0); __builtin_amdgcn_s_setprio(0); } while (0)
#define PG8_WAIT_V(n) asm volatile("s_waitcnt vmcnt(" #n ")" ::: "memory")
#define PG8_WAIT_L(n) asm volatile("s_waitcnt lgkmcnt(" #n ")" ::: "memory")
#define PG8_BAR __builtin_amdgcn_s_barrier()
#define PG8_SCHED __builtin_amdgcn_sched_barrier(0)
    Unit cur, nxt; int ui = 0;
    if (!S.next(0, cur)) return;
    f32x4 acc[2][2][4][2];
#pragma unroll
    for (int a = 0; a < 2; ++a)
#pragma unroll
        for (int b = 0; b < 2; ++b)
#pragma unroll
            for (int m = 0; m < 4; ++m)
#pragma unroll
                for (int n = 0; n < 2; ++n) acc[a][b][m][n] = (f32x4){0.f, 0.f, 0.f, 0.f};
    bf16x8 At[4][2], B0[2][2], B1[2][2];
    const char* cA = (const char*)g.A + (size_t)cur.pm * tstep; const char* cB = (const char*)g.Bt + (size_t)cur.pn * tstep;
    S.a_ready(cur);
    if constexpr (SP2) {
        PG8_STAGE(PG8_SB(0, 0), cB, voffB); PG8_STAGE(PG8_SB(0, 1), cB + hstep, voffB); PG8_STAGE(PG8_SA(0, 0), cA, voffA); PG8_STAGE(PG8_SA(0, 1), cA + hstep, voffA);
        if (wr == 1) PG8_BAR;
        PG8_WAIT_V(2); PG8_BAR;
        PG8_STAGE(PG8_SB(1, 0), cB + kstep, voffB); PG8_STAGE(PG8_SA(1, 0), cA + kstep, voffA); PG8_STAGE(PG8_SB(1, 1), cB + hstep + kstep, voffB);
        PG8_WAIT_V(6); PG8_BAR;
    } else {
        PG8_STAGE(PG8_SB(0, 0), cB, voffB); PG8_STAGE(PG8_SA(0, 0), cA, voffA); PG8_STAGE(PG8_SB(0, 1), cB + hstep, voffB); PG8_STAGE(PG8_SA(0, 1), cA + hstep, voffA);
        if (wr == 1) PG8_BAR;
        PG8_WAIT_V(4); PG8_BAR;
        PG8_STAGE(PG8_SB(1, 0), cB + kstep, voffB); PG8_STAGE(PG8_SA(1, 0), cA + kstep, voffA); PG8_STAGE(PG8_SB(1, 1), cB + hstep + kstep, voffB);
        PG8_WAIT_V(6); PG8_BAR;
    }
    for (;;) {
        const bool has_next = S.next(ui + 1, nxt);
        const char* nA = has_next ? (const char*)g.A + (size_t)nxt.pm * tstep : cA; const char* nB = has_next ? (const char*)g.Bt + (size_t)nxt.pn * tstep : cB;
        for (int t = 0; t < nt; t += 2) {
            const bool last = (t == nt - 2);
            const char* a1 = cA + (size_t)(t + 1) * kstep;
            const char* a2 = last ? nA : cA + (size_t)(t + 2) * kstep; const char* b2 = last ? nB : cB + (size_t)(t + 2) * kstep;
            const char* a3 = a2 + kstep; const char* b3 = b2 + kstep;
            if (last && has_next) S.a_ready(nxt);
            if constexpr (SP2) {
            PG8_LDB(B0, 0, 0); PG8_LDB(B1, 0, 1); PG8_SCHED; PG8_LDA(At, 0, 0); PG8_STAGE(PG8_SA(1, 1), a1 + hstep, voffA);
            PG8_WAIT_V(8); PG8_WAIT_L(0); PG8_BAR; PG8_MMA(0, 0, At, B0); PG8_MMA(0, 1, At, B1); PG8_BAR; PG8_SCHED;
            PG8_LDA(At, 0, 1); PG8_STAGE(PG8_SB(0, 0), b2, voffB); PG8_STAGE(PG8_SB(0, 1), b2 + hstep, voffB); PG8_STAGE(PG8_SA(0, 0), a2, voffA);
            PG8_WAIT_V(8); PG8_WAIT_L(0); PG8_BAR; PG8_MMA(1, 0, At, B0); PG8_MMA(1, 1, At, B1); PG8_BAR; PG8_SCHED;
            PG8_LDB(B0, 1, 0); PG8_LDB(B1, 1, 1); PG8_SCHED; PG8_LDA(At, 1, 0); PG8_STAGE(PG8_SA(0, 1), a2 + hstep, voffA);
            PG8_WAIT_V(8); PG8_WAIT_L(0); PG8_BAR; PG8_MMA(0, 0, At, B0); PG8_MMA(0, 1, At, B1); PG8_BAR; PG8_SCHED;
            PG8_LDA(At, 1, 1); PG8_STAGE(PG8_SB(1, 0), b3, voffB); PG8_STAGE(PG8_SB(1, 1), b3 + hstep, voffB); PG8_STAGE(PG8_SA(1, 0), a3, voffA);
            PG8_WAIT_V(8); PG8_WAIT_L(0); PG8_BAR; PG8_MMA(1, 0, At, B0); PG8_MMA(1, 1, At, B1); PG8_BAR; PG8_SCHED;
            } else {
            PG8_LDB(B0, 0, 0); PG8_SCHED; PG8_LDA(At, 0, 0); PG8_STAGE(PG8_SA(1, 1), a1 + hstep, voffA);
            PG8_WAIT_L(8); PG8_BAR; PG8_WAIT_L(0); PG8_MMA(0, 0, At, B0); PG8_BAR; PG8_SCHED;
            PG8_LDB(B1, 0, 1); PG8_STAGE(PG8_SB(0, 0), b2, voffB);
            PG8_BAR; PG8_WAIT_L(0); PG8_MMA(0, 1, At, B1); PG8_BAR;
            PG8_LDA(At, 0, 1); PG8_STAGE(PG8_SA(0, 0), a2, voffA);
            PG8_BAR; PG8_WAIT_L(0); PG8_MMA(1, 0, At, B0); PG8_BAR; PG8_SCHED;
            PG8_STAGE(PG8_SB(0, 1), b2 + hstep, voffB);
            PG8_WAIT_V(6); PG8_BAR; PG8_MMA(1, 1, At, B1); PG8_BAR;
            PG8_LDB(B0, 1, 0); PG8_SCHED; PG8_LDA(At, 1, 0); PG8_STAGE(PG8_SA(0, 1), a2 + hstep, voffA);
            PG8_WAIT_L(8); PG8_BAR; PG8_WAIT_L(0); PG8_MMA(0, 0, At, B0); PG8_BAR; PG8_SCHED;
            PG8_LDB(B1, 1, 1); PG8_STAGE(PG8_SB(1, 0), b3, voffB);
            PG8_BAR; PG8_WAIT_L(0); PG8_MMA(0, 1, At, B1); PG8_BAR;
            PG8_LDA(At, 1, 1); PG8_STAGE(PG8_SA(1, 0), a3, voffA);
            PG8_BAR; PG8_WAIT_L(0); PG8_MMA(1, 0, At, B0); PG8_BAR; PG8_SCHED;
            PG8_STAGE(PG8_SB(1, 1), b3 + hstep, voffB);
            PG8_WAIT_V(6); PG8_BAR; PG8_MMA(1, 1, At, B1); PG8_BAR;
            }
        }
        if constexpr (ALIGN_EPI) { if (wr == 0) PG8_BAR; }
        if constexpr (!Epi::AFTER_DRAIN) { E(acc, cur, wr, wc, fr, fq); S.done(cur); }
        if (!has_next) break;
#pragma unroll
        for (int a = 0; a < 2; ++a)
#pragma unroll
            for (int b = 0; b < 2; ++b)
#pragma unroll
                for (int m = 0; m < 4; ++m)
#pragma unroll
                    for (int n = 0; n < 2; ++n) acc[a][b][m][n] = (f32x4){0.f, 0.f, 0.f, 0.f};
        cur = nxt; cA = nA; cB = nB; ++ui;
        if constexpr (ALIGN_EPI) { if (wr == 1) PG8_BAR; }
    }
    PG8_WAIT_V(0);
    if constexpr (!ALIGN_EPI) { if (wr == 0) PG8_BAR; }
    PG8_BAR;
    if constexpr (Epi::AFTER_DRAIN) { E.fused(acc, cur, wr, wc, fr, fq, lds, wid, lane); S.done(cur); }
#undef PG8_SA
#undef PG8_SB
#undef PG8_STAGE
#undef PG8_LDA
#undef PG8_LDB
#undef PG8_MMA
#undef PG8_WAIT_V
#undef PG8_WAIT_L
#undef PG8_BAR
#undef PG8_SCHED
}
}

#ifndef PG8_SP2
#define PG8_SP2 true
#endif
#ifndef PG8_ALIGN
#define PG8_ALIGN true
#endif
#ifndef REP_MASK
#define REP_MASK 0
#endif
#ifndef REP2
#define REP2 0
#endif
#ifndef MEMFIRST
#define MEMFIRST 1
#endif
#ifndef SAMPLEFIRST
#define SAMPLEFIRST 1
#endif
#ifndef MK_ONE_LAUNCH
#define MK_ONE_LAUNCH 1
#endif

constexpr int NWAVES = 8, NTHR = 512;
constexpr int D = 1024, ROWS_P = 16384, ROWS_S = 128, ROWS_T = 16512, M_PAD = 16640, SEQ = 2048, NB = 8;
constexpr int IN_E = 3584, IN_O = 5152, IN_O_PAD = 5376, FF = 4096, MI = 2048, CONVD = 3072;
constexpr int NMODROW = 136, MODW = 6144;
constexpr float EPS = 1e-6f;
static_assert(ROWS_P == pg8::ROWS_P && ROWS_T == pg8::ROWS_T, "row constants");

constexpr size_t MiB = 1u << 20;
constexpr size_t WS_CTL = 0, CTL_ZERO_BYTES = 1 * MiB;
constexpr size_t WS_MOD = 1 * MiB;
constexpr size_t WS_WIE = 8 * MiB, WS_WOE = 15 * MiB, WS_WIO = 17 * MiB, WS_WOO = 28 * MiB, WS_W1 = 32 * MiB, WS_W2 = 48 * MiB;
constexpr size_t WS_XR = 64 * MiB;
constexpr size_t WS_H = 129 * MiB;
constexpr size_t WS_A2 = 162 * MiB;
constexpr size_t WS_Y1 = 129 * MiB;
constexpr size_t WS_BIG = 195 * MiB;
constexpr size_t WS_XBC = 366 * MiB;
constexpr size_t WS_SS = 464 * MiB;
constexpr size_t WS_DTB = 473 * MiB, WS_CSB = 476 * MiB;
constexpr size_t WS_RS = 480 * MiB;
constexpr size_t WS_SHB = 481 * MiB;
constexpr size_t WS_CB = 483 * MiB;
constexpr int CB_LD = 17152, CB_OFF0 = 0, CB_OFF1 = 3584, CB_OFF2 = 7680, CB_OFF3 = 13056;
constexpr size_t WS_H3 = WS_XBC;
constexpr size_t WS_END = 488 * MiB;
constexpr size_t WS_QB = WS_H, WS_OL = WS_H + 16 * MiB, WS_SSEG = WS_XBC, WS_DSEG = WS_XBC + 16 * MiB;
static_assert(WS_H + (size_t)M_PAD * D * 2 <= WS_A2 && WS_A2 + (size_t)M_PAD * D * 2 <= WS_BIG && WS_Y1 + (size_t)M_PAD * MI * 2 <= WS_BIG, "ws map 1");
static_assert(WS_BIG + (size_t)M_PAD * IN_O_PAD * 2 <= WS_XBC && WS_XBC + (size_t)M_PAD * CONVD * 2 <= WS_SS && WS_SS + (size_t)M_PAD * 128 * 4 <= WS_DTB && WS_DTB + (size_t)M_PAD * 32 * 4 <= WS_CSB && WS_CSB + (size_t)M_PAD * 32 * 4 <= WS_RS && WS_RS + (size_t)4 * M_PAD * 4 <= WS_SHB && WS_SHB + (size_t)4 * 192 * 1024 * 2 <= WS_CB && WS_CB + (size_t)64 * CB_LD * 4 <= WS_END, "ws map 2");
static_assert(WS_XR + (size_t)M_PAD * D * 4 <= WS_H && WS_WIO + (size_t)IN_O_PAD * D * 2 <= WS_WOO, "ws map 3");
constexpr int CW_BAR = 4096;

constexpr size_t O_Y = 0, O_HGP = 16908288, O_HGS = 17432576, O_SCP = 25821184, O_SCS = 25829376, O_SSMP = 25960448, O_SSMS = 28057600, O_MCP = 61612032, O_MCS = 61685760, O_END = 62865408;

constexpr int RING_BYTES = 131072, LDSCTL_OFF = RING_BYTES, MISC_OFF = LDSCTL_OFF + 320, YT_OFF = 133120, LDS_BYTES = 155648;

#define GAS __attribute__((address_space(1)))
#define LAS __attribute__((address_space(3)))
typedef unsigned short bf16;
typedef unsigned v4u __attribute__((ext_vector_type(4)));
typedef unsigned v2u __attribute__((ext_vector_type(2)));
typedef float f32x4 __attribute__((ext_vector_type(4)));
typedef float f32x16 __attribute__((ext_vector_type(16)));
typedef short bf16x8 __attribute__((ext_vector_type(8)));
typedef GAS unsigned gu32;
#define RLX_AGENT __ATOMIC_RELAXED, __HIP_MEMORY_SCOPE_AGENT
#define LDS_WAIT() asm volatile("s_waitcnt lgkmcnt(0)" ::: "memory")
#define VM_WAIT() asm volatile("s_waitcnt vmcnt(0)" ::: "memory")
typedef __bf16 bfv2 __attribute__((ext_vector_type(2)));
typedef float f32x2 __attribute__((ext_vector_type(2)));
__device__ __forceinline__ unsigned pk2(float lo, float hi) { const f32x2 v = {lo, hi}; return __builtin_bit_cast(unsigned, __builtin_convertvector(v, bfv2)); }
__device__ __forceinline__ unsigned f2bf(float f) { return pk2(f, 0.f) & 0xffffu; }
__device__ __forceinline__ float bf2f(unsigned h) { return __builtin_bit_cast(float, h << 16); }
__device__ __forceinline__ float bflo(unsigned w) { return __builtin_bit_cast(float, w << 16); }
__device__ __forceinline__ float bfhi(unsigned w) { return __builtin_bit_cast(float, w & 0xffff0000u); }
__device__ __forceinline__ float fexp_(float x) { return __builtin_amdgcn_exp2f(1.4426950408889634f * x); }
__device__ __forceinline__ float flog_(float x) { return 0.6931471805599453f * __builtin_amdgcn_logf(x); }
__device__ __forceinline__ float sigmoidf_(float x) { return __builtin_amdgcn_rcpf(1.f + __builtin_amdgcn_exp2f(-1.4426950408889634f * x)); }
__device__ __forceinline__ float siluf_(float x) { return x * sigmoidf_(x); }
__device__ __forceinline__ float softplusf_(float x) { return x > 15.f ? x : flog_(1.f + fexp_(x)); }
__device__ __forceinline__ float frsq_(float x) { return __builtin_amdgcn_rsqf(x); }
__device__ __forceinline__ float wave_sum(float v) {
#pragma unroll
    for (int o = 1; o < 64; o <<= 1) v += __shfl_xor(v, o);
    return v;
}

#define XB_TMO      128
#define XB_XCNT(j)  (256  + 64 * (j))
#define XB_XSUB(j)  (1280 + 64 * (j))
#define XB_XGEN(j)  (2304 + 64 * (j))
#define XB_TOP      3328
#define XB_TOPGEN   3392
#define XCD_BAR_WORDS 3456
#define XB_SPIN_CAP (1u << 18)

__device__ __forceinline__ unsigned xb_ld(unsigned* p)              { return __hip_atomic_load(p, __ATOMIC_RELAXED, __HIP_MEMORY_SCOPE_AGENT); }
__device__ __forceinline__ unsigned xb_add(unsigned* p, unsigned v) { return __hip_atomic_fetch_add(p, v, __ATOMIC_RELAXED, __HIP_MEMORY_SCOPE_AGENT); }
__device__ __forceinline__ unsigned xb_xcc_id() { return (unsigned)__builtin_amdgcn_s_getreg((3 << 11) | 20) & 0xFu; }
#define XB_SPIN(cond, bar) do { unsigned _sp = 0; while (cond) { __builtin_amdgcn_s_sleep(1); \
    if ((++_sp & 255u) == 0u) { if (xb_ld(&(bar)[XB_TMO])) break; if (_sp > XB_SPIN_CAP) { atomicAdd(&(bar)[XB_TMO], 1u); break; } } } } while (0)

struct XcdBarrier {
    unsigned* bar; unsigned x;
    volatile LAS unsigned* st;
};

__device__ __forceinline__ XcdBarrier xcd_barrier_post(unsigned* bar, volatile LAS unsigned* st) {
    XcdBarrier b; b.bar = bar; b.x = xb_xcc_id(); b.st = st;
    if (threadIdx.x == 0) (void)xb_add(&bar[XB_XCNT(b.x)], 1u);
    return b;
}
__device__ __forceinline__ void xcd_barrier_complete(unsigned* bar, unsigned x, unsigned& nloc, unsigned& nx) {
    const unsigned G = gridDim.x * gridDim.y * gridDim.z;
    unsigned sum, cnt, mine, sp = 0u;
    for (;;) {
        sum = 0u; cnt = 0u; mine = 0u;
#pragma unroll
        for (unsigned j = 0; j < 16; ++j) { const unsigned c = xb_ld(&bar[XB_XCNT(j)]); sum += c; cnt += (c > 0u) ? 1u : 0u; mine = (j == x) ? c : mine; }
        if (sum == G) break;
        __builtin_amdgcn_s_sleep(1);
        if ((++sp & 255u) == 0u) { if (xb_ld(&bar[XB_TMO])) break; if (sp > XB_SPIN_CAP) { atomicAdd(&bar[XB_TMO], 1u); break; } }
    }
    nloc = mine > 0u ? mine : 1u; nx = cnt > 0u ? cnt : 1u;
}

__device__ __forceinline__ void xcd_barrier(const XcdBarrier& b) {
    asm volatile("s_waitcnt vmcnt(0)" ::: "memory");
    __syncthreads();
    if (threadIdx.x == 0) {
        unsigned* bar = b.bar;
        __builtin_amdgcn_s_waitcnt(0);
        unsigned nloc = b.st[0], nx = b.st[1];
        if (nloc == 0u) { xcd_barrier_complete(bar, b.x, nloc, nx); b.st[0] = nloc; b.st[1] = nx; }
        const unsigned old = xb_add(&bar[XB_XSUB(b.x)], 1u);
        const unsigned gen = old / nloc;
        if (old + 1u == (gen + 1u) * nloc) {
            __builtin_amdgcn_fence(__ATOMIC_RELEASE, "agent");
            asm volatile("s_waitcnt vmcnt(0)" ::: "memory");
            const unsigned og = xb_add(&bar[XB_TOP], 1u);
            const unsigned tg = og / nx;
            if (og + 1u == (tg + 1u) * nx) xb_add(&bar[XB_TOPGEN], 1u);
            else XB_SPIN(xb_ld(&bar[XB_TOPGEN]) == tg, bar);
            __builtin_amdgcn_fence(__ATOMIC_ACQUIRE, "agent");
            xb_add(&bar[XB_XGEN(b.x)], 1u);
            asm volatile("s_waitcnt vmcnt(0)" ::: "memory");
        } else {
            XB_SPIN(xb_ld(&bar[XB_XGEN(b.x)]) == gen, bar);
            __builtin_amdgcn_fence(__ATOMIC_ACQUIRE, "agent");
            asm volatile("s_waitcnt vmcnt(0)" ::: "memory");
        }
    }
    __syncthreads();
}

struct Args { const float* in[28]; float* out; unsigned char* ws; int ph_lo, ph_hi; };
struct Ctx {
    LAS unsigned char* lds; int tid, lane, wave, G, vcu, bid;
    const float* const* in; float* out; unsigned char* ws;
};
enum { I_XP = 0, I_XS, I_CP, I_CS, I_SHG, I_SSC, I_SSSM, I_SMC, I_ADAW, I_ADAB, I_NMIX, I_NMLP, I_NFIN, I_WIE, I_HLB, I_HGN, I_SCW, I_WOE, I_WIO, I_MCW, I_MCB, I_DTB, I_ALOG, I_DSK, I_MNORM, I_WOO, I_W1, I_W2 };

__device__ __forceinline__ void p0_transpose_item(const float* W, int K, int N, bf16* WT, LAS float* scr, int item, int lane) {
    const int nblk = N / 32, kb = item / nblk, nb = item % nblk, k0 = 64 * kb, n0 = 32 * nb;
    f32x4 v[8];
#pragma unroll
    for (int i = 0; i < 8; ++i) v[i] = *(const GAS f32x4*)(W + (size_t)(k0 + 8 * i + (lane >> 3)) * N + n0 + 4 * (lane & 7));
#pragma unroll
    for (int i = 0; i < 8; ++i) { LAS float* d = scr + (8 * i + (lane >> 3)) * 33 + 4 * (lane & 7); d[0] = v[i].x; d[1] = v[i].y; d[2] = v[i].z; d[3] = v[i].w; }
    LDS_WAIT(); asm volatile("" ::: "memory");
    const int c = lane & 7;
#pragma unroll
    for (int j = 0; j < 4; ++j) { const int n = (lane >> 3) + 8 * j; const LAS float* s = scr + (8 * c) * 33 + n;
        v4u o; o.x = pk2(s[0 * 33], s[1 * 33]); o.y = pk2(s[2 * 33], s[3 * 33]); o.z = pk2(s[4 * 33], s[5 * 33]); o.w = pk2(s[6 * 33], s[7 * 33]);
        *(GAS v4u*)(WT + (size_t)(n0 + n) * K + k0 + 8 * c) = o; }
    LDS_WAIT(); asm volatile("" ::: "memory");
}
__device__ __forceinline__ bf16x8 pack8(const float (&v)[8]) { v4u o; o.x = pk2(v[0], v[1]); o.y = pk2(v[2], v[3]); o.z = pk2(v[4], v[5]); o.w = pk2(v[6], v[7]); return __builtin_bit_cast(bf16x8, o); }

__device__ __forceinline__ void p0_phase(const Ctx& F) {
    float* mod = (float*)(F.ws + WS_MOD);
    for (int task = F.bid; task < 384; task += F.G) {
        const int l = task / 192, n0 = (task % 192) * 32;
        const float* W = F.in[I_ADAW] + (size_t)l * 1024 * 6144;
        f32x16 acc[5];
#pragma unroll
        for (int rt = 0; rt < 5; ++rt)
#pragma unroll
            for (int e = 0; e < 16; ++e) acc[rt][e] = 0.f;
        const int r = F.lane & 31, h = F.lane >> 5;
        float wn[8];
#pragma unroll
        for (int j = 0; j < 8; ++j) wn[j] = W[(size_t)(F.wave * 128 + 8 * h + j) * 6144 + n0 + r];
        for (int ks = 0; ks < 8; ++ks) {
            const int kb = F.wave * 128 + ks * 16 + 8 * h;
            const bf16x8 bfrag = pack8(wn);
            if (ks + 1 < 8) {
#pragma unroll
                for (int j = 0; j < 8; ++j) wn[j] = W[(size_t)(kb + 16 + j) * 6144 + n0 + r]; }
#pragma unroll
            for (int rt = 0; rt < 5; ++rt) {
                const int row = rt * 32 + r; float cv[8];
                if (row < NMODROW) {
                    const float* cp = row < 8 ? F.in[I_CP] + (size_t)row * 1024 : F.in[I_CS] + (size_t)(row - 8) * 1024;
                    const f32x4 a = *(const f32x4*)(cp + kb), b = *(const f32x4*)(cp + kb + 4);
#pragma unroll
                    for (int e = 0; e < 4; ++e) { cv[e] = siluf_(a[e]); cv[4 + e] = siluf_(b[e]); }
                } else {
#pragma unroll
                    for (int e = 0; e < 8; ++e) cv[e] = 0.f;
                }
                acc[rt] = __builtin_amdgcn_mfma_f32_32x32x16_bf16(pack8(cv), bfrag, acc[rt], 0, 0, 0);
            }
        }
        LAS float* red = (LAS float*)F.lds;
#pragma unroll
        for (int rt = 0; rt < 5; ++rt) {
#pragma unroll
            for (int e = 0; e < 16; ++e) red[(F.wave * 16 + e) * 64 + F.lane] = acc[rt][e];
            __syncthreads();
            for (int s = F.tid; s < 1024; s += NTHR) {
                float sum = 0.f;
#pragma unroll
                for (int w = 0; w < 8; ++w) sum += red[w * 1024 + s];
                const int reg = s >> 6, ln = s & 63; const int row = rt * 32 + (reg & 3) + 8 * (reg >> 2) + 4 * (ln >> 5); const int n = n0 + (ln & 31);
                if (row < NMODROW) { const float val = sum + F.in[I_ADAB][l * MODW + n]; mod[((size_t)l * NMODROW + row) * MODW + n] = val;
                    const int chunk = n >> 10; if (chunk == 0 || chunk == 3) ((bf16*)(F.ws + WS_SHB))[((size_t)(l * 2 + (chunk == 3)) * 192 + row) * 1024 + (n & 1023)] = (bf16)f2bf(val); }
            }
            __syncthreads();
        }
    }
    __syncthreads();
    LAS float* scr = (LAS float*)(F.lds + F.wave * 16384);
    const int gw = F.vcu * NWAVES + F.wave, NGW = F.G * NWAVES;
    constexpr int I0 = 16 * 112, I1 = 16 * 32, I2 = 16 * 161, I3 = 32 * 32, I4 = 16 * 128, I5 = 64 * 32;
    constexpr int NITEMS = I0 + I1 + I2 + I3 + 2 * I4 + 2 * I5;
    const bool split = (F.G == 256); constexpr int NPASS1 = 5 * 2048;
    for (int pass = 0; pass < 2; ++pass) {
    int it0, istep, iend;
    if (!split) { if (pass) break; it0 = gw; istep = NGW; iend = NITEMS; }
    else if (pass == 0) { it0 = gw; istep = NGW; iend = NPASS1; }
    else { if (F.bid < 128) break; it0 = NPASS1 + (F.bid - 128) * NWAVES + F.wave; istep = 128 * NWAVES; iend = NITEMS; }
    for (int it = it0; it < iend; it += istep) {
        int r = it;
        if (r < I0) { p0_transpose_item(F.in[I_WIE], 1024, IN_E, (bf16*)(F.ws + WS_WIE), scr, r, F.lane); continue; } r -= I0;
        if (r < I1) { p0_transpose_item(F.in[I_WOE], 1024, 1024, (bf16*)(F.ws + WS_WOE), scr, r, F.lane); continue; } r -= I1;
        if (r < I2) { p0_transpose_item(F.in[I_WIO], 1024, IN_O, (bf16*)(F.ws + WS_WIO), scr, r, F.lane); continue; } r -= I2;
        if (r < I3) { p0_transpose_item(F.in[I_WOO], 2048, 1024, (bf16*)(F.ws + WS_WOO), scr, r, F.lane); continue; } r -= I3;
        if (r < 2 * I4) { const int l = r / I4; p0_transpose_item(F.in[I_W1] + (size_t)l * 1024 * FF, 1024, FF, (bf16*)(F.ws + WS_W1 + l * 8 * MiB), scr, r % I4, F.lane); continue; } r -= 2 * I4;
        { const int l = r / I5; p0_transpose_item(F.in[I_W2] + (size_t)l * FF * 1024, FF, 1024, (bf16*)(F.ws + WS_W2 + l * 8 * MiB), scr, r % I5, F.lane); }
    }
    }
    { GAS v4u* z = (GAS v4u*)(F.ws + WS_RS); const int n16 = 4 * M_PAD * 4 / 16;
      for (int i = F.bid * NTHR + F.tid; i < n16; i += F.G * NTHR) z[i] = (v4u){0u, 0u, 0u, 0u}; }
    { GAS v4u* z = (GAS v4u*)(F.ws + WS_WIO + (size_t)IN_O * 1024 * 2); const int n16 = (IN_O_PAD - IN_O) * 1024 * 2 / 16;
      for (int i = F.bid * NTHR + F.tid; i < n16; i += F.G * NTHR) z[i] = (v4u){0u, 0u, 0u, 0u}; }
}

template <int NR> __device__ __forceinline__ void norm_rows(const Ctx& F, size_t hoff, int rowb, const float* xp, const float* xs, const f32x4 (&g4)[4], const float* mod_sh, const float* mod_s) {
    bf16* H = (bf16*)(F.ws + hoff);
    f32x4 v[NR][4];
#pragma unroll
    for (int r = 0; r < NR; ++r) { const int row = rowb + r;
        if (row < ROWS_T) { const float* xr = row < ROWS_P ? xp + (size_t)row * D : xs + (size_t)(row - ROWS_P) * D; const GAS f32x4* x4 = (const GAS f32x4*)xr + F.lane;
#pragma unroll
            for (int j = 0; j < 4; ++j) v[r][j] = x4[64 * j]; }
        else {
#pragma unroll
            for (int j = 0; j < 4; ++j) v[r][j] = (f32x4){0.f, 0.f, 0.f, 0.f}; } }
#pragma unroll
    for (int r = 0; r < NR; ++r) { const int row = rowb + r;
        GAS v2u* o = (GAS v2u*)(H + (size_t)row * D) + F.lane;
        if (row >= ROWS_T) {
#pragma unroll
            for (int j = 0; j < 4; ++j) o[64 * j] = (v2u){0u, 0u};
            continue; }
        const int mr = pg8::mod_row(row); float ss = 0.f;
#pragma unroll
        for (int j = 0; j < 4; ++j) ss += (v[r][j].x * v[r][j].x + v[r][j].y * v[r][j].y) + (v[r][j].z * v[r][j].z + v[r][j].w * v[r][j].w);
        const float rstd = frsq_(wave_sum(ss) * (1.f / D) + EPS);
#pragma unroll
        for (int j = 0; j < 4; ++j) { const int c = 4 * (F.lane + 64 * j);
            const f32x4 s4 = *(const f32x4*)(mod_s + (size_t)mr * MODW + c), h4 = *(const f32x4*)(mod_sh + (size_t)mr * MODW + c);
            const f32x4 y = v[r][j] * rstd * g4[j] * (s4 + 1.f) + h4;
            o[64 * j] = (v2u){pk2(y.x, y.y), pk2(y.z, y.w)}; }
    }
}
__device__ __forceinline__ void norm_sample_phase(const Ctx& F, size_t hoff, const float* xs, const float* g, const float* mod_sh, const float* mod_s) {
    const int gw = F.vcu * NWAVES + F.wave, NGW = F.G * NWAVES;
    f32x4 g4[4];
#pragma unroll
    for (int j = 0; j < 4; ++j) g4[j] = *(const f32x4*)(g + 4 * (F.lane + 64 * j));
    for (int row = ROWS_P + gw; row < M_PAD; row += NGW) norm_rows<1>(F, hoff, row, xs, xs, g4, mod_sh, mod_s);
}
template <int NR> __device__ __forceinline__ void xg_rows(const Ctx& F, int rowb, const float* xp, const f32x4 (&g4)[4], const float* mod_s) {
    bf16* H = (bf16*)(F.ws + WS_H); float* RS = (float*)(F.ws + WS_RS);
    f32x4 v[NR][4];
#pragma unroll
    for (int r = 0; r < NR; ++r) { const GAS f32x4* x4 = (const GAS f32x4*)(xp + (size_t)(rowb + r) * D) + F.lane;
#pragma unroll
        for (int j = 0; j < 4; ++j) v[r][j] = x4[64 * j]; }
#pragma unroll
    for (int r = 0; r < NR; ++r) { const int row = rowb + r; GAS v2u* o = (GAS v2u*)(H + (size_t)row * D) + F.lane; float ss = 0.f;
#pragma unroll
        for (int j = 0; j < 4; ++j) ss += (v[r][j].x * v[r][j].x + v[r][j].y * v[r][j].y) + (v[r][j].z * v[r][j].z + v[r][j].w * v[r][j].w);
        ss = wave_sum(ss); if (F.lane == 0) RS[row] = ss;
        const int mr = row >> 11;
#pragma unroll
        for (int j = 0; j < 4; ++j) { const int c = 4 * (F.lane + 64 * j);
            const f32x4 s4 = *(const f32x4*)(mod_s + (size_t)mr * MODW + c);
            const f32x4 y = v[r][j] * g4[j] * (s4 + 1.f);
            o[64 * j] = (v2u){pk2(y.x, y.y), pk2(y.z, y.w)}; }
    }
}
__device__ __forceinline__ void xg_phase(const Ctx& F, const float* xp, const float* xs, const float* g, const float* mod_sh, const float* mod_s) {
    const int gw = F.vcu * NWAVES + F.wave, NGW = F.G * NWAVES;
    f32x4 g4[4];
#pragma unroll
    for (int j = 0; j < 4; ++j) g4[j] = *(const f32x4*)(g + 4 * (F.lane + 64 * j));
    for (int rowb = gw * 4; rowb < ROWS_P; rowb += NGW * 4) xg_rows<4>(F, rowb, xp, g4, mod_s);
    for (int row = ROWS_P + gw; row < M_PAD; row += NGW) norm_rows<1>(F, WS_H, row, xs, xs, g4, mod_sh, mod_s);
}
template <int NR, bool BF> __device__ __forceinline__ void final_rows(const Ctx& F, int rowb, const f32x4 (&g4)[4]) {
    const float* XR = (const float*)(F.ws + WS_XR); const bf16* XRb = (const bf16*)(F.ws + WS_XR);
    f32x4 v[NR][4];
#pragma unroll
    for (int r = 0; r < NR; ++r) {
        if (BF) { const GAS v2u* x2 = (const GAS v2u*)(XRb + (size_t)(rowb + r) * D) + F.lane;
#pragma unroll
            for (int j = 0; j < 4; ++j) { const v2u w = x2[64 * j]; v[r][j] = (f32x4){bflo(w.x), bfhi(w.x), bflo(w.y), bfhi(w.y)}; } }
        else { const GAS f32x4* x4 = (const GAS f32x4*)(XR + (size_t)(rowb + r) * D) + F.lane;
#pragma unroll
            for (int j = 0; j < 4; ++j) v[r][j] = x4[64 * j]; } }
#pragma unroll
    for (int r = 0; r < NR; ++r) { GAS f32x4* o = (GAS f32x4*)(F.out + O_Y + (size_t)(rowb + r) * D) + F.lane; float ss = 0.f;
#pragma unroll
        for (int j = 0; j < 4; ++j) ss += (v[r][j].x * v[r][j].x + v[r][j].y * v[r][j].y) + (v[r][j].z * v[r][j].z + v[r][j].w * v[r][j].w);
        const float rstd = frsq_(wave_sum(ss) * (1.f / D) + EPS);
#pragma unroll
        for (int j = 0; j < 4; ++j) o[64 * j] = v[r][j] * rstd * g4[j]; }
}
__device__ __forceinline__ void final_phase(const Ctx& F) {
    const float* g = F.in[I_NFIN];
    const int gw = F.vcu * NWAVES + F.wave, NGW = F.G * NWAVES;
    f32x4 g4[4];
#pragma unroll
    for (int j = 0; j < 4; ++j) g4[j] = *(const f32x4*)(g + 4 * (F.lane + 64 * j));
    for (int rowb = gw * 4; rowb < ROWS_P; rowb += NGW * 4) final_rows<4, true>(F, rowb, g4);
    for (int row = ROWS_P + gw; row < ROWS_T; row += NGW) final_rows<1, false>(F, row, g4);
}

__device__ __forceinline__ float hgrn_lb(const Ctx& F, int c) { const float* hl = F.in[I_HLB]; return sigmoidf_(hl[512 + c] - hl[c]); }

template <int CTRL> __device__ __forceinline__ float dppf(float x) { return __builtin_bit_cast(float, __builtin_amdgcn_update_dpp(0, __builtin_bit_cast(int, x), CTRL, 0xF, 0xF, false)); }
__device__ __forceinline__ float red16(float x) {
    x += dppf<0xB1>(x); x += dppf<0x4E>(x); x += dppf<0x124>(x); x += dppf<0x128>(x); return x;
}
__device__ __forceinline__ void unpack8(const v4u a, float (&f)[8]) {
#pragma unroll
    for (int e = 0; e < 4; ++e) { f[2 * e] = bflo(a[e]); f[2 * e + 1] = bfhi(a[e]); }
}
typedef short s16x4 __attribute__((ext_vector_type(4)));
__device__ __forceinline__ bf16x8 tr16_pair(LAS unsigned char* p0, LAS unsigned char* p1) {
    const s16x4 a = __builtin_amdgcn_ds_read_tr16_b64_v4i16((LAS s16x4*)p0), b = __builtin_amdgcn_ds_read_tr16_b64_v4i16((LAS s16x4*)p1);
    return __builtin_shufflevector(a, b, 0, 1, 2, 3, 4, 5, 6, 7);
}
__device__ __forceinline__ bf16x8 cat64(v2u a, v2u b) { return __builtin_bit_cast(bf16x8, (v4u){a.x, a.y, b.x, b.y}); }
__device__ __forceinline__ bf16x8 acc_pair_bf16(f32x4 a, f32x4 b) { return __builtin_bit_cast(bf16x8, (v4u){pk2(a[0], a[1]), pk2(a[2], a[3]), pk2(b[0], b[1]), pk2(b[2], b[3])}); }
#define MFMA16(a, b, c) __builtin_amdgcn_mfma_f32_16x16x32_bf16((a), (b), (c), 0, 0, 0)

__device__ __forceinline__ void mix0_gla_seg(const Ctx& F, int unit) {
    const int seg = unit & 7, h = (unit >> 3) & 3, b = unit >> 5;
    bf16* QB = (bf16*)(F.ws + WS_QB); bf16* OL = (bf16*)(F.ws + WS_OL); float* SSEG = (float*)(F.ws + WS_SSEG); float* DSEG = (float*)(F.ws + WS_DSEG);
    const bf16* PROJ = (const bf16*)(F.ws + WS_BIG);
    constexpr int RS1 = 272, RSA = 80;
    constexpr int OFF_QD = 0, OFF_KD = 8704, OFF_KT = 17408, OFF_V = 26112, OFF_ATT = 34816, OFF_LF = 37376, OFF_PS = 53760, OFF_DEC = 55808, OFF_SSQ = 56320, OFF_OT = 57344;
    LAS unsigned char* L = F.lds;
    LAS float* LF = (LAS float*)(L + OFF_LF); LAS float* PS = (LAS float*)(L + OFF_PS); LAS float* DEC = (LAS float*)(L + OFF_DEC); LAS float* SSQ = (LAS float*)(L + OFF_SSQ);
    const int tid = F.tid, lane = F.lane, w = F.wave, g = lane >> 4, r15 = lane & 15, qq = r15 >> 2, pp = lane & 3;
    const int j1 = tid >> 4, ko = tid & 15;
    const int k2 = tid & 127, part = tid >> 7;
    float lbv[8];
#pragma unroll
    for (int e = 0; e < 8; ++e) lbv[e] = hgrn_lb(F, h * 128 + 8 * ko + e);
    float bc[8];
#pragma unroll
    for (int e = 0; e < 8; ++e) bc[e] = 0.f;
    f32x4 st[8];
#pragma unroll
    for (int i = 0; i < 8; ++i) st[i] = (f32x4){0.f, 0.f, 0.f, 0.f};
    const bf16* prow = PROJ + (size_t)(b * SEQ + seg * 256 + j1) * IN_E + h * 128 + 8 * ko;
    v4u q8 = *(const GAS v4u*)prow, z8 = *(const GAS v4u*)(prow + 512), i8 = *(const GAS v4u*)(prow + 1024);
    for (int c = 0; c < 8; ++c) {
        const int row0 = b * SEQ + seg * 256 + c * 32;
        float qf[8], kf[8];
        { float lf[8];
#pragma unroll
          for (int e = 0; e < 4; ++e) {
              qf[2 * e] = bflo(q8[e]); qf[2 * e + 1] = bfhi(q8[e]);
              const float f0 = lbv[2 * e] + (1.f - lbv[2 * e]) * sigmoidf_(bflo(z8[e])), f1 = lbv[2 * e + 1] + (1.f - lbv[2 * e + 1]) * sigmoidf_(bfhi(z8[e]));
              kf[2 * e] = 1.f - f0; kf[2 * e + 1] = 1.f - f1; lf[2 * e] = __logf(f0); lf[2 * e + 1] = __logf(f1); }
          *(LAS f32x4*)&LF[j1 * 128 + 8 * ko] = (f32x4){lf[0], lf[1], lf[2], lf[3]}; *(LAS f32x4*)&LF[j1 * 128 + 8 * ko + 4] = (f32x4){lf[4], lf[5], lf[6], lf[7]};
          *(LAS v4u*)(L + OFF_V + j1 * RS1 + 16 * ko) = i8; }
        if (c + 1 < 8) { prow += (size_t)32 * IN_E; q8 = *(const GAS v4u*)prow; z8 = *(const GAS v4u*)(prow + 512); i8 = *(const GAS v4u*)(prow + 1024); }
        __syncthreads();
        { float x[8];
#pragma unroll
          for (int e = 0; e < 8; ++e) x[e] = LF[(8 * part + e) * 128 + k2];
#pragma unroll
          for (int e = 1; e < 8; ++e) x[e] += x[e - 1];
#pragma unroll
          for (int e = 0; e < 8; ++e) LF[(8 * part + e) * 128 + k2] = x[e];
          PS[part * 128 + k2] = x[7]; }
        __syncthreads();
        { const int pj = j1 >> 3;
          f32x4 o0 = (f32x4){0.f, 0.f, 0.f, 0.f}, o1 = o0, t0 = o0, t1 = o0;
#pragma unroll
          for (int p = 0; p < 3; ++p) { const f32x4 a = *(const LAS f32x4*)&PS[p * 128 + 8 * ko], bb = *(const LAS f32x4*)&PS[p * 128 + 8 * ko + 4];
              t0 += a; t1 += bb; if (p < pj) { o0 += a; o1 += bb; } }
          const f32x4 b0 = *(const LAS f32x4*)&LF[j1 * 128 + 8 * ko] + o0, b1 = *(const LAS f32x4*)&LF[j1 * 128 + 8 * ko + 4] + o1;
          const f32x4 l0 = *(const LAS f32x4*)&LF[31 * 128 + 8 * ko] + t0, l1 = *(const LAS f32x4*)&LF[31 * 128 + 8 * ko + 4] + t1;
          float qd[8], kd[8], kt[8];
#pragma unroll
          for (int e = 0; e < 8; ++e) { const float bv = e < 4 ? b0[e & 3] : b1[e & 3], lv = e < 4 ? l0[e & 3] : l1[e & 3];
              qd[e] = qf[e] * __expf(bv); kd[e] = kf[e] * __expf(-bv); kt[e] = kf[e] * __expf(lv - bv); }
          *(LAS v4u*)(L + OFF_QD + j1 * RS1 + 16 * ko) = (v4u){pk2(qd[0], qd[1]), pk2(qd[2], qd[3]), pk2(qd[4], qd[5]), pk2(qd[6], qd[7])};
          *(LAS v4u*)(L + OFF_KD + j1 * RS1 + 16 * ko) = (v4u){pk2(kd[0], kd[1]), pk2(kd[2], kd[3]), pk2(kd[4], kd[5]), pk2(kd[6], kd[7])};
          *(LAS v4u*)(L + OFF_KT + j1 * RS1 + 16 * ko) = (v4u){pk2(kt[0], kt[1]), pk2(kt[2], kt[3]), pk2(kt[4], kt[5]), pk2(kt[6], kt[7])};
          { float qb[8];
#pragma unroll
            for (int e = 0; e < 8; ++e) qb[e] = qd[e] * fexp_(bc[e]);
            *(GAS v4u*)(QB + (size_t)(row0 + j1) * 512 + h * 128 + 8 * ko) = (v4u){pk2(qb[0], qb[1]), pk2(qb[2], qb[3]), pk2(qb[4], qb[5]), pk2(qb[6], qb[7])};
#pragma unroll
            for (int e = 0; e < 8; ++e) bc[e] += (e < 4 ? l0[e & 3] : l1[e & 3]); }
          if (j1 == 0) { *(LAS f32x4*)&DEC[8 * ko] = (f32x4){__expf(l0[0]), __expf(l0[1]), __expf(l0[2]), __expf(l0[3])}; *(LAS f32x4*)&DEC[8 * ko + 4] = (f32x4){__expf(l1[0]), __expf(l1[1]), __expf(l1[2]), __expf(l1[3])}; } }
        __syncthreads();
        if (w < 4) {
            const int it = w >> 1, jt = w & 1; f32x4 a4 = (f32x4){0.f, 0.f, 0.f, 0.f};
            if (jt <= it) {
#pragma unroll
                for (int ks = 0; ks < 4; ++ks) {
                    const bf16x8 a = *(const LAS bf16x8*)(L + OFF_QD + (16 * it + r15) * RS1 + (32 * ks + 8 * g) * 2), bb = *(const LAS bf16x8*)(L + OFF_KD + (16 * jt + r15) * RS1 + (32 * ks + 8 * g) * 2);
                    a4 = MFMA16(a, bb, a4); } }
#pragma unroll
            for (int reg = 0; reg < 4; ++reg) { const int i = 16 * it + 4 * g + reg, j = 16 * jt + r15;
                *(LAS bf16*)(L + OFF_ATT + i * RSA + 2 * j) = (bf16)f2bf(j <= i ? a4[reg] : 0.f); }
        }
        f32x4 acc_o[2] = {(f32x4){0.f, 0.f, 0.f, 0.f}, (f32x4){0.f, 0.f, 0.f, 0.f}};
#pragma unroll
        for (int ks = 0; ks < 4; ++ks) {
            const bf16x8 bfrag = acc_pair_bf16(st[2 * ks], st[2 * ks + 1]);
#pragma unroll
            for (int it = 0; it < 2; ++it) {
                const v2u a0 = *(const LAS v2u*)(L + OFF_QD + (16 * it + r15) * RS1 + (32 * ks + 4 * g) * 2), a1 = *(const LAS v2u*)(L + OFF_QD + (16 * it + r15) * RS1 + (32 * ks + 16 + 4 * g) * 2);
                acc_o[it] = MFMA16(cat64(a0, a1), bfrag, acc_o[it]); } }
        __syncthreads();
        const bf16x8 vfrag = tr16_pair(L + OFF_V + (8 * g + qq) * RS1 + (16 * w + 4 * pp) * 2, L + OFF_V + (8 * g + 4 + qq) * RS1 + (16 * w + 4 * pp) * 2);
#pragma unroll
        for (int it = 0; it < 2; ++it) { const bf16x8 a = *(const LAS bf16x8*)(L + OFF_ATT + (16 * it + r15) * RSA + 16 * g); acc_o[it] = MFMA16(a, vfrag, acc_o[it]); }
#pragma unroll
        for (int kt8 = 0; kt8 < 8; ++kt8) {
            const bf16x8 a = tr16_pair(L + OFF_KT + (8 * g + qq) * RS1 + (16 * kt8 + 4 * pp) * 2, L + OFF_KT + (8 * g + 4 + qq) * RS1 + (16 * kt8 + 4 * pp) * 2);
            const f32x4 d4 = *(const LAS f32x4*)&DEC[16 * kt8 + 4 * g];
            st[kt8] = MFMA16(a, vfrag, st[kt8] * d4); }
#pragma unroll
        for (int it = 0; it < 2; ++it)
#pragma unroll
            for (int reg = 0; reg < 4; ++reg) *(LAS bf16*)(L + OFF_OT + (16 * it + 4 * g + reg) * RS1 + (16 * w + r15) * 2) = (bf16)f2bf(acc_o[it][reg]);
        __syncthreads();
        *(GAS v4u*)(OL + (size_t)(row0 + j1) * 512 + h * 128 + 8 * ko) = *(const LAS v4u*)(L + OFF_OT + j1 * RS1 + 16 * ko);
    }
    if (j1 == 0) { *(GAS f32x4*)(DSEG + unit * 128 + 8 * ko) = (f32x4){fexp_(bc[0]), fexp_(bc[1]), fexp_(bc[2]), fexp_(bc[3])}; *(GAS f32x4*)(DSEG + unit * 128 + 8 * ko + 4) = (f32x4){fexp_(bc[4]), fexp_(bc[5]), fexp_(bc[6]), fexp_(bc[7])}; }
#pragma unroll
    for (int kt8 = 0; kt8 < 8; ++kt8) *(GAS f32x4*)(SSEG + (size_t)unit * 16384 + ((w * 8 + kt8) * 64 + lane) * 4) = st[kt8];
    __syncthreads();
}

__device__ __forceinline__ void mix0_gla_fix(const Ctx& F, int unit) {
    const int seg = unit & 7, h = (unit >> 3) & 3, b = unit >> 5;
    const bf16* PROJ = (const bf16*)(F.ws + WS_BIG); bf16* A2 = (bf16*)(F.ws + WS_A2);
    const bf16* QB = (const bf16*)(F.ws + WS_QB); const bf16* OL = (const bf16*)(F.ws + WS_OL); const float* SSEG = (const float*)(F.ws + WS_SSEG); const float* DSEG = (const float*)(F.ws + WS_DSEG);
    constexpr int RS1 = 272, RSO = 528; constexpr int OFF_QD = 0, OFF_O32 = 8704;
    LAS unsigned char* L = F.lds;
    const int tid = F.tid, lane = F.lane, w = F.wave, g = lane >> 4, r15 = lane & 15;
    const int j1 = tid >> 4, ko = tid & 15;
    float gn8[8];
#pragma unroll
    for (int e = 0; e < 8; ++e) gn8[e] = F.in[I_HGN][8 * ko + e];
    const size_t rowj = (size_t)(b * SEQ + seg * 256 + j1);
    const bf16* qrow = QB + rowj * 512 + h * 128 + 8 * ko; const bf16* orow = OL + rowj * 512 + h * 128 + 8 * ko; const bf16* grow = PROJ + rowj * IN_E + 1536 + h * 128 + 8 * ko;
    v4u q8 = *(const GAS v4u*)qrow, o8 = *(const GAS v4u*)orow, g8 = *(const GAS v4u*)grow;
    f32x4 st[8];
#pragma unroll
    for (int i = 0; i < 8; ++i) st[i] = (f32x4){0.f, 0.f, 0.f, 0.f};
    for (int sp = 0; sp < seg; ++sp) {
        const float* ss = SSEG + (size_t)(unit - seg + sp) * 16384 + (size_t)(w * 8 * 64 + lane) * 4; const float* dd = DSEG + (unit - seg + sp) * 128;
        f32x4 sv[8];
#pragma unroll
        for (int kt8 = 0; kt8 < 8; ++kt8) sv[kt8] = *(const GAS f32x4*)(ss + kt8 * 256);
#pragma unroll
        for (int kt8 = 0; kt8 < 8; ++kt8) { const f32x4 d4 = *(const f32x4*)(dd + 16 * kt8 + 4 * g); st[kt8] = st[kt8] * d4 + sv[kt8]; }
    }
    if (seg == 7) {
        float* hgp = F.out + O_HGP + (size_t)((b * 4 + h) * 128) * 128;
        const float* ss = SSEG + (size_t)unit * 16384 + (size_t)(w * 8 * 64 + lane) * 4; const float* dd = DSEG + unit * 128;
#pragma unroll
        for (int kt8 = 0; kt8 < 8; ++kt8) { const f32x4 d4 = *(const f32x4*)(dd + 16 * kt8 + 4 * g); const f32x4 fin = st[kt8] * d4 + *(const GAS f32x4*)(ss + kt8 * 256);
#pragma unroll
            for (int reg = 0; reg < 4; ++reg) hgp[(size_t)(16 * kt8 + 4 * g + reg) * 128 + 16 * w + r15] = fin[reg]; }
    }
    bf16x8 bfr[4];
#pragma unroll
    for (int ks = 0; ks < 4; ++ks) bfr[ks] = acc_pair_bf16(st[2 * ks], st[2 * ks + 1]);
    for (int c = 0; c < 8; ++c) {
        const size_t row = rowj + (size_t)c * 32;
        *(LAS v4u*)(L + OFF_QD + j1 * RS1 + 16 * ko) = q8;
        const v4u oc = o8, gc = g8;
        if (c + 1 < 8) { qrow += (size_t)32 * 512; orow += (size_t)32 * 512; grow += (size_t)32 * IN_E; q8 = *(const GAS v4u*)qrow; o8 = *(const GAS v4u*)orow; g8 = *(const GAS v4u*)grow; }
        __syncthreads();
        f32x4 acc_o[2] = {(f32x4){0.f, 0.f, 0.f, 0.f}, (f32x4){0.f, 0.f, 0.f, 0.f}};
#pragma unroll
        for (int ks = 0; ks < 4; ++ks)
#pragma unroll
            for (int it = 0; it < 2; ++it) {
                const v2u a0 = *(const LAS v2u*)(L + OFF_QD + (16 * it + r15) * RS1 + (32 * ks + 4 * g) * 2), a1 = *(const LAS v2u*)(L + OFF_QD + (16 * it + r15) * RS1 + (32 * ks + 16 + 4 * g) * 2);
                acc_o[it] = MFMA16(cat64(a0, a1), bfr[ks], acc_o[it]); }
#pragma unroll
        for (int it = 0; it < 2; ++it)
#pragma unroll
            for (int reg = 0; reg < 4; ++reg) *(LAS float*)(L + OFF_O32 + (16 * it + 4 * g + reg) * RSO + (16 * w + r15) * 4) = acc_o[it][reg];
        __syncthreads();
        { const f32x4 c0 = *(const LAS f32x4*)(L + OFF_O32 + j1 * RSO + 32 * ko), c1 = *(const LAS f32x4*)(L + OFF_O32 + j1 * RSO + 32 * ko + 16);
          float o[8], gt[8];
          unpack8(oc, o); unpack8(gc, gt);
#pragma unroll
          for (int e = 0; e < 4; ++e) { o[e] += c0[e]; o[4 + e] += c1[e]; }
          float ss = 0.f;
#pragma unroll
          for (int e = 0; e < 8; ++e) ss += o[e] * o[e];
          const float rstd = frsq_(red16(ss) * (1.f / 128.f) + EPS);
          float y[8];
#pragma unroll
          for (int e = 0; e < 8; ++e) y[e] = o[e] * rstd * gn8[e] * siluf_(gt[e]);
          *(GAS v4u*)(A2 + row * D + h * 128 + 8 * ko) = (v4u){pk2(y[0], y[1]), pk2(y[2], y[3]), pk2(y[4], y[5]), pk2(y[6], y[7])}; }
    }
    __syncthreads();
}

__device__ __forceinline__ void mix0_gla_sample(const Ctx& F, int bs, int h) {
    const bf16* PROJ = (const bf16*)(F.ws + WS_BIG); bf16* A2 = (bf16*)(F.ws + WS_A2);
    LAS float* qs = (LAS float*)F.lds; LAS float* fs = qs + 128; LAS float* ssum = qs + 256; LAS float* red = qs + 512;
    const int v4 = F.tid & 31, kq = F.tid >> 5, row = ROWS_P + bs;
    const bf16* pr = PROJ + (size_t)row * IN_E + h * 128;
    const size_t base = (size_t)((bs * 4 + h) * 128) * 128;
    const float* s0p = F.in[I_SHG] + base + (size_t)(8 * kq) * 128 + 4 * v4; float* s1p = F.out + O_HGS + base + (size_t)(8 * kq) * 128 + 4 * v4;
    f32x4 s0[8];
#pragma unroll
    for (int kk = 0; kk < 8; ++kk) s0[kk] = *(const f32x4*)(s0p + (size_t)kk * 128);
    if (F.tid < 128) { const float lb = hgrn_lb(F, h * 128 + F.tid); qs[F.tid] = bf2f(pr[F.tid]); fs[F.tid] = lb + (1.f - lb) * sigmoidf_(bf2f(pr[512 + F.tid])); }
    const v2u iv = *(const GAS v2u*)(pr + 1024 + 4 * v4);
    const f32x4 vt = (f32x4){bflo(iv.x), bfhi(iv.x), bflo(iv.y), bfhi(iv.y)};
    __syncthreads();
    f32x4 po = (f32x4){0.f, 0.f, 0.f, 0.f};
#pragma unroll
    for (int kk = 0; kk < 8; ++kk) { const float f = fs[8 * kq + kk], q = qs[8 * kq + kk]; const f32x4 s = s0[kk] * f + vt * (1.f - f); *(f32x4*)(s1p + (size_t)kk * 128) = s; po += s * q; }
    *(LAS f32x4*)&red[kq * 128 + 4 * v4] = po;
    __syncthreads();
    float o = 0.f;
    if (F.tid < 128) {
#pragma unroll
        for (int q = 0; q < 16; ++q) o += red[q * 128 + F.tid];
        const float sw = wave_sum(o * o); if (F.lane == 0) ssum[F.wave] = sw; }
    __syncthreads();
    if (h == 0) {
        const int c = F.tid; const bf16* prs = PROJ + (size_t)row * IN_E; const float* wsc = F.in[I_SCW]; const float* stp = F.in[I_SSC] + (size_t)bs * 1024;
        const float bg = bf2f(prs[2048 + c]), u0 = bf2f(prs[2560 + c]) * bf2f(prs[3072 + c]), u2 = stp[c], u1 = stp[512 + c];
        F.out[O_SCS + (size_t)bs * 1024 + c] = u1; F.out[O_SCS + (size_t)bs * 1024 + 512 + c] = u0;
        A2[(size_t)row * D + 512 + c] = (bf16)f2bf(bg * (wsc[c] * u2 + wsc[512 + c] * u1 + wsc[1024 + c] * u0));
    }
    if (F.tid < 128) { const float rstd = frsq_((ssum[0] + ssum[1]) * (1.f / 128.f) + EPS); const float g = bf2f(pr[1536 + F.tid]);
        A2[(size_t)row * D + h * 128 + F.tid] = (bf16)f2bf(o * rstd * F.in[I_HGN][F.tid] * siluf_(g)); }
    __syncthreads();
}

__device__ __forceinline__ void mix0_sc(const Ctx& F, int unit) {
    const bf16* PROJ = (const bf16*)(F.ws + WS_BIG); bf16* A2 = (bf16*)(F.ws + WS_A2);
    const int o = F.tid & 63, rg = F.tid >> 6, c0 = 8 * o;
    const float* wp = F.in[I_SCW];
    float w0[8], w1[8], w2[8];
#pragma unroll
    for (int e = 0; e < 8; ++e) { w0[e] = wp[c0 + e]; w1[e] = wp[512 + c0 + e]; w2[e] = wp[1024 + c0 + e]; }
    float u1[8], u2[8];
    const int rowb = unit * 64 + 8 * rg;
    const bool prompt = unit < 256;
    if (prompt) {
        const int t = rowb & (SEQ - 1);
        float a[8], b[8];
        if (t >= 1) { unpack8(*(const GAS v4u*)(PROJ + (size_t)(rowb - 1) * IN_E + 2560 + c0), a); unpack8(*(const GAS v4u*)(PROJ + (size_t)(rowb - 1) * IN_E + 3072 + c0), b);
#pragma unroll
            for (int e = 0; e < 8; ++e) u1[e] = a[e] * b[e]; }
        else {
#pragma unroll
            for (int e = 0; e < 8; ++e) u1[e] = 0.f; }
        if (t >= 2) { unpack8(*(const GAS v4u*)(PROJ + (size_t)(rowb - 2) * IN_E + 2560 + c0), a); unpack8(*(const GAS v4u*)(PROJ + (size_t)(rowb - 2) * IN_E + 3072 + c0), b);
#pragma unroll
            for (int e = 0; e < 8; ++e) u2[e] = a[e] * b[e]; }
        else {
#pragma unroll
            for (int e = 0; e < 8; ++e) u2[e] = 0.f; }
    }
#pragma unroll 2
    for (int r = 0; r < 8; ++r) {
        const int row = rowb + r;
        const bf16* pr = PROJ + (size_t)row * IN_E;
        float bg[8], cg[8], hv[8], u0[8];
        unpack8(*(const GAS v4u*)(pr + 2048 + c0), bg); unpack8(*(const GAS v4u*)(pr + 2560 + c0), cg); unpack8(*(const GAS v4u*)(pr + 3072 + c0), hv);
#pragma unroll
        for (int e = 0; e < 8; ++e) u0[e] = cg[e] * hv[e];
        if (!prompt) { const int bs = row - ROWS_P; const float* stp = F.in[I_SSC] + (size_t)bs * 1024 + c0;
            const f32x4 a0 = *(const f32x4*)stp, a1 = *(const f32x4*)(stp + 4), b0 = *(const f32x4*)(stp + 512), b1 = *(const f32x4*)(stp + 516);
#pragma unroll
            for (int e = 0; e < 4; ++e) { u2[e] = a0[e]; u2[4 + e] = a1[e]; u1[e] = b0[e]; u1[4 + e] = b1[e]; }
            float* so = F.out + O_SCS + (size_t)bs * 1024 + c0;
            *(f32x4*)so = b0; *(f32x4*)(so + 4) = b1; *(f32x4*)(so + 512) = (f32x4){u0[0], u0[1], u0[2], u0[3]}; *(f32x4*)(so + 516) = (f32x4){u0[4], u0[5], u0[6], u0[7]};
        } else if ((row & (SEQ - 1)) == SEQ - 1) { float* so = F.out + O_SCP + (size_t)(row >> 11) * 1024 + c0;
            *(f32x4*)so = (f32x4){u1[0], u1[1], u1[2], u1[3]}; *(f32x4*)(so + 4) = (f32x4){u1[4], u1[5], u1[6], u1[7]};
            *(f32x4*)(so + 512) = (f32x4){u0[0], u0[1], u0[2], u0[3]}; *(f32x4*)(so + 516) = (f32x4){u0[4], u0[5], u0[6], u0[7]}; }
        float y[8];
#pragma unroll
        for (int e = 0; e < 8; ++e) y[e] = bg[e] * (w0[e] * u2[e] + w1[e] * u1[e] + w2[e] * u0[e]);
        *(GAS v4u*)(A2 + (size_t)row * D + 512 + c0) = (v4u){pk2(y[0], y[1]), pk2(y[2], y[3]), pk2(y[4], y[5]), pk2(y[6], y[7])};
#pragma unroll
        for (int e = 0; e < 8; ++e) { u2[e] = u1[e]; u1[e] = u0[e]; }
    }
}
__device__ __forceinline__ void mix0_phaseA(const Ctx& F) {
    constexpr int NG = 256, NU1 = 512, NU2 = ROWS_P / 64;
    const bool mem_first = (MEMFIRST == 2) ? ((F.bid & 1) != 0) : (MEMFIRST == 1);
    for (int pass = 0; pass < 2; ++pass) {
        if ((pass == 0) == mem_first) {
            for (int rep = 0; rep < ((REP2 & 2) ? 2 : 1); ++rep)
            for (int u = F.bid; u < NU1 + NU2; u += F.G) {
                if (u < NU2) mix0_sc(F, u);
                else mix0_gla_sample(F, (u - NU2) >> 2, (u - NU2) & 3);
            }
        } else {
            for (int rep = 0; rep < ((REP2 & 1) ? 2 : 1); ++rep)
            for (int u = F.bid; u < NG; u += F.G) mix0_gla_seg(F, u);
        }
    }
}
__device__ __forceinline__ void mix0_phaseB(const Ctx& F) { for (int rep = 0; rep < ((REP2 & 16) ? 2 : 1); ++rep) for (int u = F.bid; u < 256; u += F.G) mix0_gla_fix(F, u); }

__device__ __forceinline__ void conv1_phase(const Ctx& F) {
    const bf16* PROJ = (const bf16*)(F.ws + WS_BIG); bf16* XBC = (bf16*)(F.ws + WS_XBC);
    float* DTB = (float*)(F.ws + WS_DTB); float* CSB = (float*)(F.ws + WS_CSB);
    if (F.tid >= 416) return;
    if (F.tid >= 384) {
        const int hd = F.tid - 384; const float A = -fexp_(F.in[I_ALOG][hd]), dtb = F.in[I_DTB][hd];
        for (int unit = F.vcu; unit < ROWS_T / 64; unit += F.G) {
            const int row0 = unit * 64; float run = 0.f;
            for (int r8 = 0; r8 < 64; r8 += 8) {
                unsigned short raw[8];
#pragma unroll
                for (int e = 0; e < 8; ++e) raw[e] = PROJ[(size_t)(row0 + r8 + e) * IN_O_PAD + 5120 + hd];
#pragma unroll
                for (int e = 0; e < 8; ++e) { const float dt = softplusf_(bf2f(raw[e]) + dtb); run += dt * A; DTB[(size_t)(row0 + r8 + e) * 32 + hd] = dt; CSB[(size_t)(row0 + r8 + e) * 32 + hd] = run; }
            }
        }
        return;
    }
    const int c0 = 8 * F.tid;
    const float* wp = F.in[I_MCW];
    float w0[8], w1[8], w2[8], w3[8], bs8[8];
#pragma unroll
    for (int e = 0; e < 8; ++e) { w0[e] = wp[c0 + e]; w1[e] = wp[CONVD + c0 + e]; w2[e] = wp[2 * CONVD + c0 + e]; w3[e] = wp[3 * CONVD + c0 + e]; bs8[e] = F.in[I_MCB][c0 + e]; }
    for (int unit = F.vcu; unit < ROWS_P / 16; unit += F.G) {
        const int row0 = unit * 16; const bool head = (row0 & (SEQ - 1)) == 0;
        v4u raw[19];
#pragma unroll
        for (int e = 0; e < 19; ++e) raw[e] = (e < 3 && head) ? (v4u){0u, 0u, 0u, 0u} : *(const GAS v4u*)(PROJ + (size_t)(row0 - 3 + e) * IN_O_PAD + 2048 + c0);
        float u1[8], u2[8], u3[8];
        unpack8(raw[0], u3); unpack8(raw[1], u2); unpack8(raw[2], u1);
#pragma unroll
        for (int rr = 0; rr < 16; ++rr) {
            const int row = row0 + rr; float u0[8];
            unpack8(raw[3 + rr], u0);
            if (rr == 15 && (row & (SEQ - 1)) == SEQ - 1) {
                float* so = F.out + O_MCP + (size_t)(row >> 11) * 3 * CONVD + c0;
#pragma unroll
                for (int e = 0; e < 8; ++e) { so[e] = u2[e]; so[CONVD + e] = u1[e]; so[2 * CONVD + e] = u0[e]; } }
            float y[8];
#pragma unroll
            for (int e = 0; e < 8; ++e) y[e] = siluf_(w0[e] * u3[e] + w1[e] * u2[e] + w2[e] * u1[e] + w3[e] * u0[e] + bs8[e]);
            *(GAS v4u*)(XBC + (size_t)row * CONVD + c0) = (v4u){pk2(y[0], y[1]), pk2(y[2], y[3]), pk2(y[4], y[5]), pk2(y[6], y[7])};
#pragma unroll
            for (int e = 0; e < 8; ++e) { u3[e] = u2[e]; u2[e] = u1[e]; u1[e] = u0[e]; }
        }
    }
    for (int bsi = F.vcu; bsi < ROWS_S; bsi += F.G) {
        const int row = ROWS_P + bsi;
        if (F.tid < 32) *(GAS f32x4*)((float*)(F.ws + WS_SS) + (size_t)row * 128 + 4 * F.tid) = (f32x4){0.f, 0.f, 0.f, 0.f}; float u0[8], u1[8], u2[8], u3[8];
        unpack8(*(const GAS v4u*)(PROJ + (size_t)row * IN_O_PAD + 2048 + c0), u0);
        const float* stp = F.in[I_SMC] + (size_t)bsi * 3 * CONVD + c0;
#pragma unroll
        for (int e = 0; e < 8; ++e) { u3[e] = stp[e]; u2[e] = stp[CONVD + e]; u1[e] = stp[2 * CONVD + e]; }
        float* so = F.out + O_MCS + (size_t)bsi * 3 * CONVD + c0;
#pragma unroll
        for (int e = 0; e < 8; ++e) { so[e] = u2[e]; so[CONVD + e] = u1[e]; so[2 * CONVD + e] = u0[e]; }
        float y[8];
#pragma unroll
        for (int e = 0; e < 8; ++e) y[e] = siluf_(w0[e] * u3[e] + w1[e] * u2[e] + w2[e] * u1[e] + w3[e] * u0[e] + bs8[e]);
        *(GAS v4u*)(XBC + (size_t)row * CONVD + c0) = (v4u){pk2(y[0], y[1]), pk2(y[2], y[3]), pk2(y[4], y[5]), pk2(y[6], y[7])};
    }
}

__device__ __forceinline__ void mix1_ssd_sample(const Ctx& F, int bs, int hq, int lds_off = 0) {
    const bf16* PROJ = (const bf16*)(F.ws + WS_BIG); const bf16* XBC = (const bf16*)(F.ws + WS_XBC); bf16* Y1 = (bf16*)(F.ws + WS_Y1); float* SS = (float*)(F.ws + WS_SS);
    LAS float* yl = (LAS float*)(F.lds + lds_off);
    const int g = hq >> 1, p = F.tid >> 3, sq = F.tid & 7, row = ROWS_P + bs;
    const bf16* xb = XBC + (size_t)row * CONVD; const bf16* pr = PROJ + (size_t)row * IN_O_PAD;
    f32x4 s0[4][4];
#pragma unroll
    for (int hh = 0; hh < 4; ++hh) { const float* sp = F.in[I_SSSM] + ((size_t)(bs * 32 + 4 * hq + hh) * 64 + p) * 128 + sq * 16;
#pragma unroll
        for (int j4 = 0; j4 < 4; ++j4) s0[hh][j4] = *(const f32x4*)(sp + j4 * 4); }
    f32x4 Bv[4], Cv[4];
#pragma unroll
    for (int j4 = 0; j4 < 4; ++j4) { const v2u b4 = *(const GAS v2u*)(xb + 2048 + g * 128 + sq * 16 + j4 * 4), c4 = *(const GAS v2u*)(xb + 2560 + g * 128 + sq * 16 + j4 * 4);
        Bv[j4] = (f32x4){bflo(b4.x), bfhi(b4.x), bflo(b4.y), bfhi(b4.y)}; Cv[j4] = (f32x4){bflo(c4.x), bfhi(c4.x), bflo(c4.y), bfhi(c4.y)}; }
#pragma unroll
    for (int hh = 0; hh < 4; ++hh) {
        const int hd = 4 * hq + hh;
        const float A = -fexp_(F.in[I_ALOG][hd]), Dk = F.in[I_DSK][hd], dtb = F.in[I_DTB][hd];
        const float xv = bf2f(xb[hd * 64 + p]), dt = softplusf_(bf2f(pr[5120 + hd]) + dtb), dA = fexp_(dt * A), dtx = dt * xv;
        float* s1 = F.out + O_SSMS + ((size_t)(bs * 32 + hd) * 64 + p) * 128 + sq * 16;
        f32x4 ya = (f32x4){0.f, 0.f, 0.f, 0.f};
#pragma unroll
        for (int j4 = 0; j4 < 4; ++j4) { const f32x4 s = s0[hh][j4] * dA + Bv[j4] * dtx; *(f32x4*)(s1 + j4 * 4) = s; ya += Cv[j4] * s; }
        float y = (ya[0] + ya[1]) + (ya[2] + ya[3]);
        y += __shfl_xor(y, 1); y += __shfl_xor(y, 2); y += __shfl_xor(y, 4);
        const float yg = (y + Dk * xv) * siluf_(bf2f(pr[hd * 64 + p]));
        if (sq == 0) { Y1[(size_t)row * MI + hd * 64 + p] = (bf16)f2bf(yg); yl[hh * 64 + p] = yg * yg; }
    }
    __syncthreads();
    if (F.wave < 4) { const float ss = wave_sum(yl[F.wave * 64 + F.lane]); if (F.lane < 4) SS[(size_t)row * 128 + (4 * hq + F.wave) * 4 + F.lane] = F.lane == 0 ? ss : 0.f; }
    __syncthreads();
}

__device__ __forceinline__ unsigned ssd_tile(int idx) {
    const unsigned long long tab = (0ull) | (1ull << 6) | ((1ull | (1ull << 2)) << 12) | (2ull << 18) | ((2ull | (1ull << 2)) << 24) | ((2ull | (2ull << 2)) << 30) | (3ull << 36) | ((3ull | (1ull << 2)) << 42)
                                 | ((3ull | (2ull << 2)) << 48) | ((3ull | (3ull << 2)) << 54);
    if (idx < 10) return (unsigned)(tab >> (6 * idx)) & 63u;
    return idx == 10 ? (0u | (1u << 2) | 16u) : (2u | (3u << 2) | 16u);
}
__device__ __forceinline__ void mix1_ssd_prompt(const Ctx& F, int b, int hd, int su0 = -1, int sustep = 0) {
    const bf16* PROJ = (const bf16*)(F.ws + WS_BIG); const bf16* XBC = (const bf16*)(F.ws + WS_XBC); bf16* Y1 = (bf16*)(F.ws + WS_Y1); float* SS = (float*)(F.ws + WS_SS);
    const float* DTB = (const float*)(F.ws + WS_DTB); const float* CSB = (const float*)(F.ws + WS_CSB);
    constexpr int RSB = 272, RSX = 144, RSW = 144;
    constexpr int OFF_BR = 0, OFF_CR = 17408, OFF_X = 34816, OFF_XW = 44032, OFF_W = 53248, OFF_CS = 62464, OFF_DT = 62720, SET = 62976;
    static_assert(2 * SET <= RING_BYTES, "two image sets fit the LDS ring");
    LAS unsigned char* L0 = F.lds;
    const int tid = F.tid, lane = F.lane, w = F.wave, g = lane >> 4, r15 = lane & 15, qq = r15 >> 2, pp = lane & 3;
    const int ps = w & 3, ih = w >> 2, grp = hd >> 3;
    const float Dk = F.in[I_DSK][hd];
    f32x4 st[8];
#pragma unroll
    for (int i = 0; i < 8; ++i) st[i] = (f32x4){0.f, 0.f, 0.f, 0.f};
    const int jb = tid >> 4, ob = tid & 15, jx = tid >> 3, ox = tid & 7;
    const bf16* gB = XBC + (size_t)(b * SEQ + jb) * CONVD + 2048 + grp * 128 + 8 * ob;
    const bf16* gX = XBC + (size_t)(b * SEQ + jx) * CONVD + hd * 64 + 8 * ox;
    const float* gS = (tid < 64 ? CSB : DTB) + (size_t)(b * SEQ + (tid & 63)) * 32 + hd;
    v4u B0, B1, C0, C1, X0; float sv = 0.f;
#define SSD_LOAD() do { B0 = *(const GAS v4u*)gB; B1 = *(const GAS v4u*)(gB + (size_t)32 * CONVD); C0 = *(const GAS v4u*)(gB + 512); C1 = *(const GAS v4u*)(gB + 512 + (size_t)32 * CONVD); X0 = *(const GAS v4u*)gX; \
        if (tid < 128) sv = *gS; gB += (size_t)64 * CONVD; gX += (size_t)64 * CONVD; gS += 64 * 32; } while (0)
#define SSD_STAGE(Ls) do { *(LAS v4u*)((Ls) + OFF_BR + jb * RSB + 16 * ob) = B0; *(LAS v4u*)((Ls) + OFF_BR + (jb + 32) * RSB + 16 * ob) = B1; \
        *(LAS v4u*)((Ls) + OFF_CR + jb * RSB + 16 * ob) = C0; *(LAS v4u*)((Ls) + OFF_CR + (jb + 32) * RSB + 16 * ob) = C1; *(LAS v4u*)((Ls) + OFF_X + jx * RSX + 16 * ox) = X0; \
        if (tid < 128) *(LAS float*)((Ls) + (tid < 64 ? OFF_CS : OFF_DT) + 4 * (tid & 63)) = sv; } while (0)
#define SSD_P2(Ls) do { const LAS float* CSp = (const LAS float*)((Ls) + OFF_CS); const LAS float* DTp = (const LAS float*)((Ls) + OFF_DT); \
        { const float fac = fexp_(CSp[63] - CSp[jx]) * DTp[jx]; const v4u Xc = *(const LAS v4u*)((Ls) + OFF_X + jx * RSX + 16 * ox); \
          *(LAS v4u*)((Ls) + OFF_XW + jx * RSX + 16 * ox) = (v4u){pk2(bflo(Xc.x) * fac, bfhi(Xc.x) * fac), pk2(bflo(Xc.y) * fac, bfhi(Xc.y) * fac), pk2(bflo(Xc.z) * fac, bfhi(Xc.z) * fac), pk2(bflo(Xc.w) * fac, bfhi(Xc.w) * fac)}; } \
        _Pragma("unroll") for (int rep = 0; rep < 2; ++rep) { const int idx = w + 8 * rep; \
            if (idx < 12) { const unsigned tc = ssd_tile(idx); const int it = tc & 3, jt = (tc >> 2) & 3; const bool zero = (tc & 16u) != 0u; \
                f32x4 a4 = (f32x4){0.f, 0.f, 0.f, 0.f}; \
                if (!zero) { _Pragma("unroll") for (int ks = 0; ks < 4; ++ks) { \
                        const bf16x8 a = *(const LAS bf16x8*)((Ls) + OFF_BR + (16 * jt + r15) * RSB + (32 * ks + 8 * g) * 2), bb = *(const LAS bf16x8*)((Ls) + OFF_CR + (16 * it + r15) * RSB + (32 * ks + 8 * g) * 2); \
                        a4 = MFMA16(a, bb, a4); } } \
                const int i = 16 * it + r15; const float csi = CSp[i]; float wv[4]; \
                const f32x4 cj = *(const LAS f32x4*)&CSp[16 * jt + 4 * g], dj = *(const LAS f32x4*)&DTp[16 * jt + 4 * g]; \
                _Pragma("unroll") for (int reg = 0; reg < 4; ++reg) { const int j = 16 * jt + 4 * g + reg; wv[reg] = (!zero && j <= i) ? a4[reg] * fexp_(csi - cj[reg]) * dj[reg] : 0.f; } \
                *(LAS v2u*)((Ls) + OFF_W + i * RSW + (16 * jt + 4 * g) * 2) = (v2u){pk2(wv[0], wv[1]), pk2(wv[2], wv[3])}; } } } while (0)
    SSD_LOAD(); SSD_STAGE(L0); SSD_LOAD();
    __syncthreads();
    SSD_P2(L0); SSD_STAGE(L0 + SET); SSD_LOAD();
    __syncthreads();
    float smy = 0.f;
    v4u z8 = *(const GAS v4u*)(PROJ + (size_t)(b * SEQ + (tid >> 3)) * IN_O_PAD + hd * 64 + 8 * (tid & 7));
    for (int c = 0; c < 32; ++c) {
        const int row0 = b * SEQ + c * 64;
        LAS unsigned char* L = L0 + (c & 1) * SET; LAS unsigned char* Ln = L0 + ((c + 1) & 1) * SET;
        const LAS float* CS = (const LAS float*)(L + OFF_CS);
        const float csl = CS[63];
        f32x4 sm0, sm1; v2u smb0, smb1, smc0, smc1; size_t smoff = 0; int smrow = 0, smhd = 0;
        if (su0 >= 0) { const int job = c >> 1, su = su0 + (job >> 2) * sustep; smrow = ROWS_P + (su >> 3); smhd = 4 * (su & 7) + (job & 3);
            smoff = ((size_t)((su >> 3) * 32 + smhd) * 64 + (tid >> 3)) * 128 + (tid & 7) * 16 + 8 * (c & 1);
            const float* sp = F.in[I_SSSM] + smoff; sm0 = *(const GAS f32x4*)sp; sm1 = *(const GAS f32x4*)(sp + 4);
            const bf16* xbs = XBC + (size_t)smrow * CONVD + 2048 + (smhd >> 3) * 128 + (tid & 7) * 16 + 8 * (c & 1);
            smb0 = *(const GAS v2u*)xbs; smb1 = *(const GAS v2u*)(xbs + 4); smc0 = *(const GAS v2u*)(xbs + 512); smc1 = *(const GAS v2u*)(xbs + 516); }
        f32x4 acc_y[2];
#pragma unroll
        for (int t2 = 0; t2 < 2; ++t2) {
            const int it = 2 * ih + t2; f32x4 acc = (f32x4){0.f, 0.f, 0.f, 0.f};
#pragma unroll
            for (int ks = 0; ks < 4; ++ks) {
                const bf16x8 bfrag = acc_pair_bf16(st[2 * ks], st[2 * ks + 1]);
                const v2u a0 = *(const LAS v2u*)(L + OFF_CR + (16 * it + r15) * RSB + (32 * ks + 4 * g) * 2), a1 = *(const LAS v2u*)(L + OFF_CR + (16 * it + r15) * RSB + (32 * ks + 16 + 4 * g) * 2);
                acc = MFMA16(cat64(a0, a1), bfrag, acc); }
            const f32x4 c4 = *(const LAS f32x4*)&CS[16 * it + 4 * g];
            acc = acc * (f32x4){fexp_(c4[0]), fexp_(c4[1]), fexp_(c4[2]), fexp_(c4[3])};
#pragma unroll
            for (int ks = 0; ks < 2; ++ks) {
                if (ks <= ih) {
                    const bf16x8 a = *(const LAS bf16x8*)(L + OFF_W + (16 * it + r15) * RSW + (32 * ks + 8 * g) * 2);
                    const bf16x8 xf = tr16_pair(L + OFF_X + (32 * ks + 8 * g + qq) * RSX + (16 * ps + 4 * pp) * 2, L + OFF_X + (32 * ks + 8 * g + 4 + qq) * RSX + (16 * ps + 4 * pp) * 2);
                    acc = MFMA16(a, xf, acc); } }
            acc_y[t2] = acc;
        }
        { const float el = fexp_(csl);
          const bf16x8 xw0 = tr16_pair(L + OFF_XW + (8 * g + qq) * RSX + (16 * ps + 4 * pp) * 2, L + OFF_XW + (8 * g + 4 + qq) * RSX + (16 * ps + 4 * pp) * 2);
          const bf16x8 xw1 = tr16_pair(L + OFF_XW + (32 + 8 * g + qq) * RSX + (16 * ps + 4 * pp) * 2, L + OFF_XW + (32 + 8 * g + 4 + qq) * RSX + (16 * ps + 4 * pp) * 2);
#pragma unroll
          for (int stl = 0; stl < 8; ++stl) {
              const bf16x8 a0 = tr16_pair(L + OFF_BR + (8 * g + qq) * RSB + (16 * stl + 4 * pp) * 2, L + OFF_BR + (8 * g + 4 + qq) * RSB + (16 * stl + 4 * pp) * 2);
              const bf16x8 a1 = tr16_pair(L + OFF_BR + (32 + 8 * g + qq) * RSB + (16 * stl + 4 * pp) * 2, L + OFF_BR + (32 + 8 * g + 4 + qq) * RSB + (16 * stl + 4 * pp) * 2);
              f32x4 s = st[stl] * el; s = MFMA16(a0, xw0, s); st[stl] = MFMA16(a1, xw1, s); } }
        if (c + 1 < 32) SSD_P2(Ln);
#pragma unroll
        for (int t2 = 0; t2 < 2; ++t2)
#pragma unroll
            for (int reg = 0; reg < 4; ++reg) {
                const int i = 16 * (2 * ih + t2) + 4 * g + reg;
                const float xv = bf2f(*(const LAS bf16*)(L + OFF_X + i * RSX + (16 * ps + r15) * 2));
                *(LAS float*)(L0 + YT_OFF + i * 272 + (16 * ps + r15) * 4) = acc_y[t2][reg] + Dk * xv; }
        __syncthreads();
        if (c + 2 < 32) { SSD_STAGE(L); if (c + 3 < 32) SSD_LOAD(); }
        { const int ie = tid >> 3, oe = tid & 7;
          const f32x4 y0 = *(const LAS f32x4*)(L0 + YT_OFF + ie * 272 + 32 * oe), y1 = *(const LAS f32x4*)(L0 + YT_OFF + ie * 272 + 32 * oe + 16);
          float z[8]; unpack8(z8, z);
          float yg[8];
#pragma unroll
          for (int e = 0; e < 4; ++e) { yg[e] = y0[e] * siluf_(z[e]); yg[4 + e] = y1[e] * siluf_(z[4 + e]); }
          *(GAS v4u*)(Y1 + (size_t)(row0 + ie) * MI + hd * 64 + 8 * oe) = (v4u){pk2(yg[0], yg[1]), pk2(yg[2], yg[3]), pk2(yg[4], yg[5]), pk2(yg[6], yg[7])};
          float ss = 0.f;
#pragma unroll
          for (int e = 0; e < 8; ++e) ss += yg[e] * yg[e];
          ss += dppf<0xB1>(ss); ss += dppf<0x4E>(ss); ss += __shfl_xor(ss, 4);
          if (oe == 0) *(GAS f32x4*)(SS + (size_t)(row0 + ie) * 128 + hd * 4) = (f32x4){ss, 0.f, 0.f, 0.f};
          if (c + 1 < 32) z8 = *(const GAS v4u*)(PROJ + (size_t)(row0 + 64 + ie) * IN_O_PAD + hd * 64 + 8 * oe); }
        if (su0 >= 0) {
            const int p = tid >> 3;
            const float dts = DTB[(size_t)smrow * 32 + smhd], xvs = bf2f(XBC[(size_t)smrow * CONVD + smhd * 64 + p]);
            const float dAs = fexp_(-dts * fexp_(F.in[I_ALOG][smhd])), dtx = dts * xvs;
            const f32x4 bv0 = (f32x4){bflo(smb0.x), bfhi(smb0.x), bflo(smb0.y), bfhi(smb0.y)}, bv1 = (f32x4){bflo(smb1.x), bfhi(smb1.x), bflo(smb1.y), bfhi(smb1.y)};
            const f32x4 cv0 = (f32x4){bflo(smc0.x), bfhi(smc0.x), bflo(smc0.y), bfhi(smc0.y)}, cv1 = (f32x4){bflo(smc1.x), bfhi(smc1.x), bflo(smc1.y), bfhi(smc1.y)};
            const f32x4 n0 = sm0 * dAs + bv0 * dtx, n1 = sm1 * dAs + bv1 * dtx;
            float* so = F.out + O_SSMS + smoff; *(GAS f32x4*)so = n0; *(GAS f32x4*)(so + 4) = n1;
            const f32x4 pr = cv0 * n0 + cv1 * n1; const float yp = (pr[0] + pr[1]) + (pr[2] + pr[3]);
            smy = (c & 1) ? smy + yp : yp;
            if (c & 1) { float y = smy; y += dppf<0xB1>(y); y += dppf<0x4E>(y); y += __shfl_xor(y, 4);
                const float yg = (y + F.in[I_DSK][smhd] * xvs) * siluf_(bf2f(PROJ[(size_t)smrow * IN_O_PAD + smhd * 64 + p]));
                float ss = ((tid & 7) == 0) ? yg * yg : 0.f;
                if ((tid & 7) == 0) Y1[(size_t)smrow * MI + smhd * 64 + p] = (bf16)f2bf(yg);
                ss = wave_sum(ss); if (lane == 0) (void)__hip_atomic_fetch_add(SS + (size_t)smrow * 128 + smhd * 4, ss, __ATOMIC_RELAXED, __HIP_MEMORY_SCOPE_AGENT); }
        }
        __syncthreads();
    }
#undef SSD_LOAD
#undef SSD_STAGE
#undef SSD_P2
    if (ih == 0) {
        float* sp = F.out + O_SSMP + ((size_t)(b * 32 + hd) * 64 + 16 * ps + r15) * 128;
#pragma unroll
        for (int stl = 0; stl < 8; ++stl) *(f32x4*)(sp + 16 * stl + 4 * g) = st[stl];
    }
}

__device__ __forceinline__ void mix1_phase(const Ctx& F) {
    constexpr int NU0 = 256, NU1 = ROWS_S * 8;
    if (F.G == NU0 && !SAMPLEFIRST) { mix1_ssd_prompt(F, F.vcu >> 5, F.vcu & 31, F.vcu, NU0); return; }
    if (SAMPLEFIRST) { for (int u = F.vcu; u < NU1; u += F.G) mix1_ssd_sample(F, u >> 3, u & 7); for (int u = F.vcu; u < NU0; u += F.G) mix1_ssd_prompt(F, u >> 5, u & 31); return; }
    for (int u = F.vcu; u < NU0; u += F.G) mix1_ssd_prompt(F, u >> 5, u & 31);
    for (int u = F.vcu; u < NU1; u += F.G) mix1_ssd_sample(F, u >> 3, u & 7);
}
template <int NR> __device__ __forceinline__ void norm1_rows(const Ctx& F, int rowb) {
    bf16* Y1 = (bf16*)(F.ws + WS_Y1); const float* SS = (const float*)(F.ws + WS_SS); const float* mn = F.in[I_MNORM];
    v4u y8[NR][4]; float sv[NR];
#pragma unroll
    for (int r = 0; r < NR; ++r) { const int row = rowb + r; const GAS v4u* yp = (const GAS v4u*)(Y1 + (size_t)row * MI) + F.lane;
        if (row < ROWS_T) {
#pragma unroll
            for (int i = 0; i < 4; ++i) y8[r][i] = yp[64 * i];
            sv[r] = SS[(size_t)row * 128 + 2 * F.lane] + SS[(size_t)row * 128 + 2 * F.lane + 1]; }
        else { sv[r] = 0.f;
#pragma unroll
            for (int i = 0; i < 4; ++i) y8[r][i] = (v4u){0u, 0u, 0u, 0u}; } }
#pragma unroll
    for (int r = 0; r < NR; ++r) { const int row = rowb + r; GAS v4u* yp = (GAS v4u*)(Y1 + (size_t)row * MI) + F.lane;
        float s = sv[r];
        s += __shfl_xor(s, 1); s += __shfl_xor(s, 2); s += __shfl_xor(s, 4); s += __shfl_xor(s, 8);
        const float rs = row < ROWS_T ? frsq_(s * (1.f / 512.f) + EPS) : 0.f;
#pragma unroll
        for (int i = 0; i < 4; ++i) {
            const float rr = __shfl(rs, 16 * i); const int c = (i * 64 + F.lane) * 8;
            const f32x4 m0 = *(const f32x4*)(mn + c), m1 = *(const f32x4*)(mn + c + 4); const v4u yy = y8[r][i];
            v4u o;
            o.x = pk2(bflo(yy.x) * rr * m0[0], bfhi(yy.x) * rr * m0[1]); o.y = pk2(bflo(yy.y) * rr * m0[2], bfhi(yy.y) * rr * m0[3]);
            o.z = pk2(bflo(yy.z) * rr * m1[0], bfhi(yy.z) * rr * m1[1]); o.w = pk2(bflo(yy.w) * rr * m1[2], bfhi(yy.w) * rr * m1[3]);
            yp[64 * i] = o; }
    }
}
__device__ __forceinline__ void norm1_phase(const Ctx& F) {
    const int gw = F.vcu * NWAVES + F.wave, NGW = F.G * NWAVES;
    for (int rowb = gw * 4; rowb < ROWS_P; rowb += NGW * 4) norm1_rows<4>(F, rowb);
    for (int row = ROWS_P + gw; row < M_PAD; row += NGW) norm1_rows<1>(F, row);
}

template <int EPI>
__device__ __forceinline__ void sgemm_run(const Ctx& F, const bf16* A, int lda, const bf16* Bt, int K, int KS, int rb0, int nrb, int cb0, int ncb, int uoff,
                                          bf16* O, int ldc, const float* xin_p, const float* xin_s, float* XRp, const float* gate, const float* rsq = nullptr, const float* cbv = nullptr, int ldcb = 0, int wg0 = 0, int nwg = 0) {
    constexpr int RS = 528, OFF_A = 0, OFF_B = 64 * RS, STAGE = 96 * RS;
    LAS unsigned char* L = F.lds;
    const int tid = F.tid, lane = F.lane, w = F.wave, g = lane >> 4, r15 = lane & 15, rt = w >> 1, ct = w & 1;
    const int lr = tid >> 5, lo = tid & 31;
    const int total = nrb * ncb * KS, klen = K / KS, nch = klen / 256;
    for (int rep = 0; rep < (((REP2 & 32) && KS == 1) ? 2 : 1); ++rep) {
    const int NW = nwg > 0 ? nwg : F.G, li = F.bid - wg0;
    if (li < 0 || li >= NW) continue;
    int u = (NW - 1 - li) - (uoff % NW); if (u < 0) u += NW;
    for (; u < total; u += NW) {
        const int ks = u % KS, t = u / KS, cb = cb0 + t % ncb, rb = rb0 + t / ncb;
        const bf16* ap = A + (size_t)(64 * rb + lr) * lda + ks * klen + 8 * lo;
        const bf16* bp = Bt + (size_t)(32 * cb + lr) * K + ks * klen + 8 * lo;
        v4u a0[4], b0[2];
#pragma unroll
        for (int i = 0; i < 4; ++i) a0[i] = *(const GAS v4u*)(ap + (size_t)(16 * i) * lda);
#pragma unroll
        for (int i = 0; i < 2; ++i) b0[i] = *(const GAS v4u*)(bp + (size_t)(16 * i) * K);
        f32x4 acc = (f32x4){0.f, 0.f, 0.f, 0.f};
        for (int c = 0; c < nch; ++c) {
            LAS unsigned char* S = L + (c & 1) * STAGE;
#pragma unroll
            for (int i = 0; i < 4; ++i) *(LAS v4u*)(S + OFF_A + (lr + 16 * i) * RS + 16 * lo) = a0[i];
#pragma unroll
            for (int i = 0; i < 2; ++i) *(LAS v4u*)(S + OFF_B + (lr + 16 * i) * RS + 16 * lo) = b0[i];
            if (c + 1 < nch) { ap += 256; bp += 256;
#pragma unroll
                for (int i = 0; i < 4; ++i) a0[i] = *(const GAS v4u*)(ap + (size_t)(16 * i) * lda);
#pragma unroll
                for (int i = 0; i < 2; ++i) b0[i] = *(const GAS v4u*)(bp + (size_t)(16 * i) * K); }
            __syncthreads();
#pragma unroll
            for (int q = 0; q < 8; ++q) {
                const bf16x8 af = *(const LAS bf16x8*)(S + OFF_A + (16 * rt + r15) * RS + (32 * q + 8 * g) * 2), bf = *(const LAS bf16x8*)(S + OFF_B + (16 * ct + r15) * RS + (32 * q + 8 * g) * 2);
                acc = MFMA16(bf, af, acc); }
        }
        __syncthreads();
        const int token = 64 * rb + 16 * rt + r15, n = 32 * cb + 16 * ct + 4 * g;
        if (EPI == 3) { *(f32x4*)(XRp + (size_t)token * ldc + n) = acc; }
        else if (EPI == 4) { const float rstd = frsq_(rsq[token] * (1.f / D) + EPS); const f32x4 c4 = *(const f32x4*)(cbv + (size_t)(token >> 11) * ldcb + n); const f32x4 y = acc * rstd + c4;
            *(GAS v2u*)(O + (size_t)token * ldc + n) = (v2u){pk2(y[0], y[1]), pk2(y[2], y[3])}; }
        else if (EPI == 0 || EPI == 1) {
            if (EPI == 1) {
#pragma unroll
                for (int e = 0; e < 4; ++e) { const float r = fmaxf(acc[e], 0.f); acc[e] = r * r; } }
            *(GAS v2u*)(O + (size_t)token * ldc + n) = (v2u){pk2(acc[0], acc[1]), pk2(acc[2], acc[3])};
        } else {
            const f32x4 g4 = *(const f32x4*)(gate + (size_t)pg8::mod_row(token) * MODW + n);
            float* op = XRp + (size_t)token * D + n;
            if (KS == 1) { const float* xr = token < ROWS_P ? xin_p + (size_t)token * D : xin_s + (size_t)(token - ROWS_P) * D; *(f32x4*)op = *(const f32x4*)(xr + n) + g4 * acc; }
            else {
#pragma unroll
                for (int e = 0; e < 4; ++e) (void)__hip_atomic_fetch_add(op + e, g4[e] * acc[e], __ATOMIC_RELAXED, __HIP_MEMORY_SCOPE_AGENT); }
        }
    }
    }
}

constexpr int NPHASE = 18;
__global__ void __launch_bounds__(NTHR, 2) mega_fwd(Args args) {
    extern __shared__ __attribute__((aligned(16))) unsigned char lds_raw[];
    Ctx F;
    F.lds = (LAS unsigned char*)lds_raw;
    F.tid = threadIdx.x; F.lane = F.tid & 63; F.wave = __builtin_amdgcn_readfirstlane(F.tid >> 6);
    F.G = gridDim.x; F.bid = blockIdx.x; F.vcu = (F.G % 8 == 0) ? (F.bid % 8) * (F.G / 8) + F.bid / 8 : F.bid;
    F.in = args.in; F.out = args.out; F.ws = args.ws;
    volatile LAS unsigned* MISC = (volatile LAS unsigned*)(F.lds + MISC_OFF);
    for (int u = F.tid; u < (LDS_BYTES - LDSCTL_OFF) / 4; u += NTHR) ((LAS unsigned*)(F.lds + LDSCTL_OFF))[u] = 0u;
    __syncthreads();
    const int lo = args.ph_lo, hi = args.ph_hi;
    XcdBarrier bar; bar.bar = (unsigned*)(F.ws + WS_CTL) + CW_BAR; bar.x = 0; bar.st = nullptr;
    if (hi - lo > 1) bar = xcd_barrier_post((unsigned*)(F.ws + WS_CTL) + CW_BAR, MISC + 8);

    float* mod = (float*)(F.ws + WS_MOD);
    float* XR = (float*)(F.ws + WS_XR);
    float* modL1 = mod + (size_t)NMODROW * MODW;
#define IN(k) (lo <= (k) && (k) < hi)
#define SEAM(k) do { if ((k) + 1 < hi) { xcd_barrier(bar); if (REP2 & 64) xcd_barrier(bar); } } while (0)
#define GEMM_BF16(ACT, Aoff, Boff, Ooff, N_, LDC_, K_, RSi, CBo) do { pg8::Gemm g{(const bf16*)(F.ws + (Aoff)), (const bf16*)(F.ws + (Boff)), ROWS_P, (N_), (K_)}; pg8::StaticOrder S; S.init(ROWS_P, (N_), F.G, F.bid); \
        pg8::EpiBf16<ACT> E{(bf16*)(F.ws + (Ooff)), (LDC_), RSB + (size_t)(RSi) * M_PAD, CBB + (CBo), CB_LD}; pg8::gemm_phase<pg8::EpiBf16<ACT>, pg8::StaticOrder, PG8_ALIGN, PG8_SP2>(F.lds, g, S, E); } while (0)
#define GEMM_RES(XF32, Aoff, Boff, K_, xp_, gate_, XGoff, gnw_, smod_, RSi) do { pg8::Gemm g{(const bf16*)(F.ws + (Aoff)), (const bf16*)(F.ws + (Boff)), ROWS_P, D, (K_)}; pg8::StaticOrder S; S.init(ROWS_P, D, F.G, F.bid); \
        pg8::EpiRes<XF32> E{(const void*)(xp_), XRb, (gate_), (RSi) < 0 ? nullptr : (bf16*)(F.ws + (XGoff)), (gnw_), (smod_), RSB + (size_t)((RSi) < 0 ? 0 : (RSi)) * M_PAD}; pg8::gemm_phase<pg8::EpiRes<XF32>, pg8::StaticOrder, PG8_ALIGN, PG8_SP2>(F.lds, g, S, E); } while (0)
#define SG_BF16(ACT, Aoff, Boff, Ooff, LDC_, K_, rb0_, nrb_, nt0_, nnt_, uoff_) sgemm_run<ACT>(F, (const bf16*)(F.ws + (Aoff)), (K_), (const bf16*)(F.ws + (Boff)), (K_), 1, (rb0_), (nrb_), (nt0_), (nnt_), (uoff_), \
        (bf16*)(F.ws + (Ooff)), (LDC_), nullptr, nullptr, nullptr, nullptr)
#define SG_RES(Aoff, Boff, K_, KS_, xp_, xs_, gate_) sgemm_run<2>(F, (const bf16*)(F.ws + (Aoff)), (K_), (const bf16*)(F.ws + (Boff)), (K_), (KS_), 256, 2, 0, D / 32, 0, nullptr, 0, (xp_), (xs_), XR, (gate_))
#define SG_CB(idx, Boff, ncb_, CBo, uoff_, wg0_, nwg_) sgemm_run<3>(F, (const bf16*)(F.ws + WS_SHB) + (size_t)(idx) * 192 * 1024, 1024, (const bf16*)(F.ws + (Boff)), 1024, 1, 0, 1, 0, (ncb_), (uoff_), nullptr, CB_LD, nullptr, nullptr, CBB + (CBo), nullptr, nullptr, nullptr, 0, (wg0_), (nwg_))
    float* RSB = (float*)(F.ws + WS_RS); float* CBB = (float*)(F.ws + WS_CB);
    float* XRS = XR + (size_t)ROWS_P * D;
    bf16* XRb = (bf16*)XR;
    if (IN(0)) { p0_phase(F); if ((REP_MASK >> 0) & 1) { xcd_barrier(bar); p0_phase(F); } SEAM(0); }
    if (IN(1)) { xg_phase(F, F.in[I_XP], F.in[I_XS], F.in[I_NMIX], mod + 0 * D, mod + 1 * D);
                 SG_CB(0, WS_WIE, IN_E / 32, CB_OFF0, 0, 0, 0); SEAM(1); }
    if (IN(2)) { GEMM_BF16(0, WS_H, WS_WIE, WS_BIG, IN_E, IN_E, D, 0, CB_OFF0); SG_BF16(0, WS_H, WS_WIE, WS_BIG, IN_E, D, 256, 2, 0, IN_E / 32, 0);
                 if (F.G == 256) { SG_CB(1, WS_W1, FF / 32, CB_OFF1, 0, 128, 128); SG_CB(2, WS_WIO, IN_O / 32, CB_OFF2, 128, 128, 128); SG_CB(3, WS_W1 + 8 * MiB, FF / 32, CB_OFF3, 289, 128, 128); }
                 else { SG_CB(1, WS_W1, FF / 32, CB_OFF1, 0, 0, 0); SG_CB(2, WS_WIO, IN_O / 32, CB_OFF2, 128, 0, 0); SG_CB(3, WS_W1 + 8 * MiB, FF / 32, CB_OFF3, 289, 0, 0); } SEAM(2); }
    if (IN(3)) { mix0_phaseA(F); xcd_barrier(bar); mix0_phaseB(F); if ((REP_MASK >> 3) & 1) { xcd_barrier(bar); mix0_phaseA(F); xcd_barrier(bar); mix0_phaseB(F); } SEAM(3); }
    if (IN(4)) { GEMM_RES(true, WS_A2, WS_WOE, D, F.in[I_XP], mod + 2 * D, WS_H, F.in[I_NMLP], mod + 4 * D, 1); SG_RES(WS_A2, WS_WOE, D, 1, F.in[I_XP], F.in[I_XS], mod + 2 * D); SEAM(4); }
    if (IN(5)) { norm_sample_phase(F, WS_H, XRS, F.in[I_NMLP], mod + 3 * D, mod + 4 * D); if (REP2 & 128) { xcd_barrier(bar); norm_sample_phase(F, WS_H, XRS, F.in[I_NMLP], mod + 3 * D, mod + 4 * D); } SEAM(5); }
    if (IN(6)) { GEMM_BF16(1, WS_H, WS_W1, WS_BIG, FF, FF, D, 1, CB_OFF1); SG_BF16(1, WS_H, WS_W1, WS_BIG, FF, D, 256, 2, 0, FF / 32, 0); SEAM(6); }
    if (IN(7)) { GEMM_RES(false, WS_BIG, WS_W2, FF, XRb, mod + 5 * D, WS_H, F.in[I_NMIX] + D, modL1 + 1 * D, 2); SG_RES(WS_BIG, WS_W2, FF, 4, XR, XRS, mod + 5 * D); SEAM(7); }
    if (IN(8)) { norm_sample_phase(F, WS_H, XRS, F.in[I_NMIX] + D, modL1 + 0 * D, modL1 + 1 * D); if (REP2 & 128) { xcd_barrier(bar); norm_sample_phase(F, WS_H, XRS, F.in[I_NMIX] + D, modL1 + 0 * D, modL1 + 1 * D); } SEAM(8); }
    if (IN(9)) { GEMM_BF16(0, WS_H, WS_WIO, WS_BIG, 5120, IN_O_PAD, D, 2, CB_OFF2); SG_BF16(0, WS_H, WS_WIO, WS_BIG, IN_O_PAD, D, 256, 2, 0, IN_O / 32, 0);
                 sgemm_run<4>(F, (const bf16*)(F.ws + WS_H), D, (const bf16*)(F.ws + WS_WIO), D, 1, 0, 256, 160, 1, 2 * (IN_O / 32), (bf16*)(F.ws + WS_BIG), IN_O_PAD, nullptr, nullptr, nullptr, nullptr, RSB + (size_t)2 * M_PAD, CBB + CB_OFF2, CB_LD); SEAM(9); }
    if (IN(10)) { conv1_phase(F); if ((REP_MASK >> 10) & 1) { xcd_barrier(bar); conv1_phase(F); } SEAM(10); }
    if (IN(11)) { mix1_phase(F); if ((REP_MASK >> 11) & 1) { xcd_barrier(bar); mix1_phase(F); } SEAM(11); }
    if (IN(12)) { norm1_phase(F); SEAM(12); }
    if (IN(13)) { GEMM_RES(false, WS_Y1, WS_WOO, MI, XRb, modL1 + 2 * D, WS_H3, F.in[I_NMLP] + D, modL1 + 4 * D, 3); SG_RES(WS_Y1, WS_WOO, MI, 4, XR, XRS, modL1 + 2 * D); SEAM(13); }
    if (IN(14)) { norm_sample_phase(F, WS_H3, XRS, F.in[I_NMLP] + D, modL1 + 3 * D, modL1 + 4 * D); SEAM(14); }
    if (IN(15)) { GEMM_BF16(1, WS_H3, WS_W1 + 8 * MiB, WS_BIG, FF, FF, D, 3, CB_OFF3); SG_BF16(1, WS_H3, WS_W1 + 8 * MiB, WS_BIG, FF, D, 256, 2, 0, FF / 32, 0); SEAM(15); }
    if (IN(16)) { GEMM_RES(false, WS_BIG, WS_W2 + 8 * MiB, FF, XRb, modL1 + 5 * D, WS_H, nullptr, nullptr, -1); SG_RES(WS_BIG, WS_W2 + 8 * MiB, FF, 4, XR, XRS, modL1 + 5 * D); SEAM(16); }
    if (IN(17)) { final_phase(F); }
#undef IN
#undef SEAM
}

extern "C" void kernel_launch(void* const* d_in, const int* in_sizes, int n_in, void* d_out, int out_size, void* d_ws, size_t ws_size, hipStream_t stream) {
    static int grid = 0;
    if (grid == 0) {
        if (n_in != 28 || out_size != (int)O_END || ws_size < WS_END) { fprintf(stderr, "kernel_launch: unexpected shapes: n_in %d out %d ws %zu\n", n_in, out_size, ws_size); grid = -1; return; }
        int dev = 0, cus = 0, per_cu = 0;
        if (hipGetDevice(&dev) != hipSuccess || hipDeviceGetAttribute(&cus, hipDeviceAttributeMultiprocessorCount, dev) != hipSuccess) { grid = -1; return; }
        if (hipFuncSetAttribute((const void*)mega_fwd, hipFuncAttributeMaxDynamicSharedMemorySize, LDS_BYTES) != hipSuccess) { fprintf(stderr, "kernel_launch: hipFuncSetAttribute failed\n"); grid = -1; return; }
        if (hipOccupancyMaxActiveBlocksPerMultiprocessor(&per_cu, (const void*)mega_fwd, NTHR, LDS_BYTES) != hipSuccess || per_cu < 1)
            fprintf(stderr, "kernel_launch: occupancy query reports %d workgroups per CU\n", per_cu);
        (void)hipGetLastError();
        grid = cus;
    }
    if (grid < 0) return;
    (void)hipMemsetAsync((char*)d_ws + WS_CTL, 0, CTL_ZERO_BYTES, stream);
    Args a{};
    for (int i = 0; i < 28; ++i) a.in[i] = (const float*)d_in[i];
    a.out = (float*)d_out; a.ws = (unsigned char*)d_ws;
#if MK_ONE_LAUNCH
    a.ph_lo = 0; a.ph_hi = NPHASE;
    hipLaunchKernelGGL(mega_fwd, dim3(grid), dim3(NTHR), LDS_BYTES, stream, a);
#else
    for (int ph = 0; ph < NPHASE; ++ph) { a.ph_lo = ph; a.ph_hi = ph + 1; hipLaunchKernelGGL(mega_fwd, dim3(grid), dim3(NTHR), LDS_BYTES, stream, a); }
#endif
}
```

```cpp
#include <hip/hip_runtime.h>
#include <cstdio>
#include <cstdint>
namespace pg8 {
#define PG8_LAS __attribute__((address_space(3)))
typedef unsigned short bf16_t;
typedef short bf16x8 __attribute__((ext_vector_type(8)));
typedef float f32x4 __attribute__((ext_vector_type(4)));
typedef unsigned u32x4 __attribute__((ext_vector_type(4)));
constexpr int BM = 256, BK = 64, HALF = 128, HTB = HALF * BK * 2  , STAGE_BYTES = 8 * HTB, NXCD = 8, WGM = 8;

__host__ __device__ __forceinline__ int lds_byte(int r, int c) { const int st = (r >> 4) * 2 + (c >> 5), rr = r & 15, cc = c & 31, ob = rr * 64 + cc * 2; return st * 1024 + (ob ^ (((ob >> 9) & 1) << 5)); }
__host__ __device__ __forceinline__ void stage_rc(int b, int& R, int& C) { const int st = b / 1024, sb = b % 1024, swz = sb ^ (((sb >> 9) & 1) << 5); R = (st >> 1) * 16 + swz / 64; C = (st & 1) * 32 + (swz % 64) / 2; }
__host__ __device__ __forceinline__ int perm32(int rho) { const int n = rho >> 4, i = rho & 15; return 8 * (i >> 2) + 4 * n + (i & 3); }

struct Unit { int pm, pn; };
struct Gemm { const bf16_t* A; const bf16_t* Bt; int M, N, K; };

struct StaticOrder {
    int nM, nN, nwg, G, c;
    __host__ __device__ void init(int M, int N, int G_, int c_) { nM = M / BM; nN = N / BM; nwg = nM * nN; G = G_; c = c_; }
    __host__ __device__ bool next(int i, Unit& u) const {
        const long L = (long)i * G + c; if (L >= nwg) return false;
        int wgid = (int)L; { const int q = nwg / NXCD, r = nwg % NXCD, xcd = wgid % NXCD, off = wgid / NXCD; wgid = (xcd < r ? xcd * (q + 1) : r * (q + 1) + (xcd - r) * q) + off; }
        const int nig = WGM * nN, gid = wgid / nig, fm = gid * WGM, gsz = (nM - fm) < WGM ? (nM - fm) : WGM;
        u.pm = fm + ((wgid % nig) % gsz); u.pn = (wgid % nig) / gsz; return true;
    }
    __device__ __forceinline__ void a_ready(const Unit&) const {}
    __device__ __forceinline__ void done(const Unit&) const {}
};

__device__ __forceinline__ unsigned cvt_pk_bf16(float lo, float hi) { unsigned r; asm volatile("v_cvt_pk_bf16_f32 %0, %1, %2" : "=v"(r) : "v"(lo), "v"(hi)); return r; }

constexpr int ROWS_P = 16384, ROWS_T = 16512;
__device__ __forceinline__ int mod_row(int row) { return row < ROWS_P ? (row >> 11) : (row - ROWS_P + 8); }

template <int ACT> struct EpiBf16 {
    static constexpr bool PERM = true, AFTER_DRAIN = false;
    bf16_t* O; int ldc; const float* rs; const float* cb; int ldcb;
    __device__ __forceinline__ void operator()(const f32x4 (&acc)[2][2][4][2], const Unit& u, int wr, int wc, int fr, int fq) const {
        const int row0 = u.pm * BM + wr * 64 + fr; const int col0 = u.pn * BM + wc * 32 + 8 * fq;
        const float* cbr = cb + (size_t)(u.pm >> 3) * ldcb + col0;
        f32x4 cv[2][2];
#pragma unroll
        for (int bj = 0; bj < 2; ++bj) { cv[bj][0] = *(const f32x4*)(cbr + bj * HALF); cv[bj][1] = *(const f32x4*)(cbr + bj * HALF + 4); }
#pragma unroll
        for (int ai = 0; ai < 2; ++ai)
#pragma unroll
            for (int m = 0; m < 4; ++m) { const int row = row0 + ai * HALF + m * 16; bf16_t* rowp = O + (size_t)row * ldc + col0;
                const float rstd = __builtin_amdgcn_rsqf(rs[row] * (1.0f / 1024.0f) + 1e-6f);
#pragma unroll
                for (int bj = 0; bj < 2; ++bj) { f32x4 v0 = acc[ai][bj][m][0] * rstd + cv[bj][0], v1 = acc[ai][bj][m][1] * rstd + cv[bj][1];
                    if (ACT == 1) {
#pragma unroll
                        for (int e = 0; e < 4; ++e) { const float a = fmaxf(v0[e], 0.f), b = fmaxf(v1[e], 0.f); v0[e] = a * a; v1[e] = b * b; } }
                    u32x4 w; w.x = cvt_pk_bf16(v0[0], v0[1]); w.y = cvt_pk_bf16(v0[2], v0[3]); w.z = cvt_pk_bf16(v1[0], v1[1]); w.w = cvt_pk_bf16(v1[2], v1[3]);
                    *(u32x4*)(rowp + bj * HALF) = w; } }
    }
};

template <bool XIN_F32> struct EpiRes {
    static constexpr bool PERM = false, AFTER_DRAIN = false;
    const void* xin; bf16_t* out; const float* gate;
    bf16_t* xg; const float* gnw; const float* smod; float* rs_out;
    __device__ __forceinline__ void operator()(const f32x4 (&acc)[2][2][4][2], const Unit& u, int wr, int wc, int fr, int fq) const {
        typedef unsigned u32x2v __attribute__((ext_vector_type(2)));
        const int col0 = u.pn * BM + wc * 32 + 4 * fq; const int b = u.pm >> 3;
        const float* gr = gate + (size_t)b * 6144;
        f32x4 g4[2][2], gm[2][2];
#pragma unroll
        for (int bj = 0; bj < 2; ++bj)
#pragma unroll
            for (int n = 0; n < 2; ++n) { const int c = col0 + bj * HALF + n * 16; g4[bj][n] = *(const f32x4*)(gr + c);
                if (xg) gm[bj][n] = *(const f32x4*)(gnw + c) * (*(const f32x4*)(smod + (size_t)b * 6144 + c) + 1.0f); }
#pragma unroll
        for (int ai = 0; ai < 2; ++ai)
#pragma unroll
            for (int m = 0; m < 4; ++m) { const int row = u.pm * BM + ai * HALF + wr * 64 + m * 16 + fr; float ss = 0.f;
#pragma unroll
                for (int bj = 0; bj < 2; ++bj)
#pragma unroll
                    for (int n = 0; n < 2; ++n) { const int c = col0 + bj * HALF + n * 16; f32x4 x4;
                        if (XIN_F32) x4 = *(const f32x4*)((const float*)xin + (size_t)row * 1024 + c);
                        else { const u32x2v xb = *(const u32x2v*)((const bf16_t*)xin + (size_t)row * 1024 + c);
                            x4 = (f32x4){__builtin_bit_cast(float, xb.x << 16), __builtin_bit_cast(float, xb.x & 0xffff0000u), __builtin_bit_cast(float, xb.y << 16), __builtin_bit_cast(float, xb.y & 0xffff0000u)}; }
                        const f32x4 o4 = x4 + g4[bj][n] * acc[ai][bj][m][n];
                        u32x2v ow; ow.x = cvt_pk_bf16(o4[0], o4[1]); ow.y = cvt_pk_bf16(o4[2], o4[3]); *(u32x2v*)(out + (size_t)row * 1024 + c) = ow;
                        if (xg) { ss += (o4[0] * o4[0] + o4[1] * o4[1]) + (o4[2] * o4[2] + o4[3] * o4[3]); const f32x4 y = o4 * gm[bj][n];
                            u32x2v w; w.x = cvt_pk_bf16(y[0], y[1]); w.y = cvt_pk_bf16(y[2], y[3]); *(u32x2v*)(xg + (size_t)row * 1024 + c) = w; } }
                if (xg) { ss += __shfl_xor(ss, 16); ss += __shfl_xor(ss, 32); if (fq == 0) (void)__hip_atomic_fetch_add(rs_out + row, ss, __ATOMIC_RELAXED, __HIP_MEMORY_SCOPE_AGENT); } }
    }
};

template <class Epi, class Sched, bool ALIGN_EPI = false, bool SP2 = false>
__device__ __forceinline__ void gemm_phase(PG8_LAS unsigned char* lds, const Gemm g, const Sched& S, const Epi& E) {
    const int tid = threadIdx.x, wid = __builtin_amdgcn_readfirstlane(tid >> 6), lane = tid & 63, wr = wid >> 2, wc = wid & 3, fr = lane & 15, fq = lane >> 4;
    const int K = g.K, nt = K / BK;
    unsigned voffA[2], voffB[2];
#pragma unroll
    for (int i = 0; i < 2; ++i) { int R, C; stage_rc(tid * 16 + i * 8192, R, C); const int Rb = Epi::PERM ? ((R & ~31) + perm32(R & 31)) : R;
        voffA[i] = (unsigned)(R * K + C) * 2u; voffB[i] = (unsigned)(Rb * K + C) * 2u; }
    const size_t kstep = (size_t)(BK * 2);
    const size_t hstep = (size_t)HALF * K * 2;
    const size_t tstep = 2 * hstep;
    const unsigned ldsw = (unsigned)wid * 1024u;
    const int aoff = lds_byte(wr * 64 + fr, fq * 8), boff = lds_byte(wc * 32 + fr, fq * 8);
#define PG8_SA(b, h) (((b) * 2 + (h)) * HTB)
#define PG8_SB(b, h) ((4 + (b) * 2 + (h)) * HTB)
#define PG8_STAGE(bufoff, gbase, voff) do { _Pragma("unroll") for (int _i = 0; _i < 2; ++_i) \
        __builtin_amdgcn_global_load_lds((const unsigned*)((const char*)(gbase) + (voff)[_i]), (PG8_LAS unsigned*)(lds + (bufoff) + ldsw + _i * 8192), 16, 0, 0); } while (0)
#define PG8_LDA(dst, b, h) do { _Pragma("unroll") for (int m = 0; m < 4; ++m) _Pragma("unroll") for (int k = 0; k < 2; ++k) dst[m][k] = *(const PG8_LAS bf16x8*)(lds + PG8_SA(b, h) + aoff + m * 2048 + k * 1024); } while (0)
#define PG8_LDB(dst, b, h) do { _Pragma("unroll") for (int n = 0; n < 2; ++n) _Pragma("unroll") for (int k = 0; k < 2; ++k) dst[n][k] = *(const PG8_LAS bf16x8*)(lds + PG8_SB(b, h) + boff + n * 2048 + k * 1024); } while (0)
#define PG8_MMA(ai, bj, At, Bt) do { __builtin_amdgcn_s_setprio(1); _Pragma("unroll") for (int m = 0; m < 4; ++m) _Pragma("unroll") for (int n = 0; n < 2; ++n) _Pragma("unroll") for (int k = 0; k < 2; ++k) \
        acc[ai][bj][m][n] = __builtin_amdgcn_mfma_f32_16x16x32_bf16(Bt[n][k], At[m][k], acc[ai][bj][m][n], 0, 0, 0); __builtin_amdgcn_s_setprio(0); } while (0)
#define PG8_WAIT_V(n) asm volatile("s_waitcnt vmcnt(" #n ")" ::: "memory")
#define PG8_WAIT_L(n) asm volatile("s_waitcnt lgkmcnt(" #n ")" ::: "memory")
#define PG8_BAR __builtin_amdgcn_s_barrier()
#define PG8_SCHED __builtin_amdgcn_sched_barrier(0)
    Unit cur, nxt; int ui = 0;
    if (!S.next(0, cur)) return;
    f32x4 acc[2][2][4][2];
#pragma unroll
    for (int a = 0; a < 2; ++a)
#pragma unroll
        for (int b = 0; b < 2; ++b)
#pragma unroll
            for (int m = 0; m < 4; ++m)
#pragma unroll
                for (int n = 0; n < 2; ++n) acc[a][b][m][n] = (f32x4){0.f, 0.f, 0.f, 0.f};
    bf16x8 At[4][2], B0[2][2], B1[2][2];
    const char* cA = (const char*)g.A + (size_t)cur.pm * tstep; const char* cB = (const char*)g.Bt + (size_t)cur.pn * tstep;
    S.a_ready(cur);
    if constexpr (SP2) {
        PG8_STAGE(PG8_SB(0, 0), cB, voffB); PG8_STAGE(PG8_SB(0, 1), cB + hstep, voffB); PG8_STAGE(PG8_SA(0, 0), cA, voffA); PG8_STAGE(PG8_SA(0, 1), cA + hstep, voffA);
        if (wr == 1) PG8_BAR;
        PG8_WAIT_V(2); PG8_BAR;
        PG8_STAGE(PG8_SB(1, 0), cB + kstep, voffB); PG8_STAGE(PG8_SA(1, 0), cA + kstep, voffA); PG8_STAGE(PG8_SB(1, 1), cB + hstep + kstep, voffB);
        PG8_WAIT_V(6); PG8_BAR;
    } else {
        PG8_STAGE(PG8_SB(0, 0), cB, voffB); PG8_STAGE(PG8_SA(0, 0), cA, voffA); PG8_STAGE(PG8_SB(0, 1), cB + hstep, voffB); PG8_STAGE(PG8_SA(0, 1), cA + hstep, voffA);
        if (wr == 1) PG8_BAR;
        PG8_WAIT_V(4); PG8_BAR;
        PG8_STAGE(PG8_SB(1, 0), cB + kstep, voffB); PG8_STAGE(PG8_SA(1, 0), cA + kstep, voffA); PG8_STAGE(PG8_SB(1, 1), cB + hstep + kstep, voffB);
        PG8_WAIT_V(6); PG8_BAR;
    }
    for (;;) {
        const bool has_next = S.next(ui + 1, nxt);
        const char* nA = has_next ? (const char*)g.A + (size_t)nxt.pm * tstep : cA; const char* nB = has_next ? (const char*)g.Bt + (size_t)nxt.pn * tstep : cB;
        for (int t = 0; t < nt; t += 2) {
            const bool last = (t == nt - 2);
            const char* a1 = cA + (size_t)(t + 1) * kstep;
            const char* a2 = last ? nA : cA + (size_t)(t + 2) * kstep; const char* b2 = last ? nB : cB + (size_t)(t + 2) * kstep;
            const char* a3 = a2 + kstep; const char* b3 = b2 + kstep;
            if (last && has_next) S.a_ready(nxt);
            if constexpr (SP2) {
            PG8_LDB(B0, 0, 0); PG8_LDB(B1, 0, 1); PG8_SCHED; PG8_LDA(At, 0, 0); PG8_STAGE(PG8_SA(1, 1), a1 + hstep, voffA);
            PG8_WAIT_V(8); PG8_WAIT_L(0); PG8_BAR; PG8_MMA(0, 0, At, B0); PG8_MMA(0, 1, At, B1); PG8_BAR; PG8_SCHED;
            PG8_LDA(At, 0, 1); PG8_STAGE(PG8_SB(0, 0), b2, voffB); PG8_STAGE(PG8_SB(0, 1), b2 + hstep, voffB); PG8_STAGE(PG8_SA(0, 0), a2, voffA);
            PG8_WAIT_V(8); PG8_WAIT_L(0); PG8_BAR; PG8_MMA(1, 0, At, B0); PG8_MMA(1, 1, At, B1); PG8_BAR; PG8_SCHED;
            PG8_LDB(B0, 1, 0); PG8_LDB(B1, 1, 1); PG8_SCHED; PG8_LDA(At, 1, 0); PG8_STAGE(PG8_SA(0, 1), a2 + hstep, voffA);
            PG8_WAIT_V(8); PG8_WAIT_L(0); PG8_BAR; PG8_MMA(0, 0, At, B0); PG8_MMA(0, 1, At, B1); PG8_BAR; PG8_SCHED;
            PG8_LDA(At, 1, 1); PG8_STAGE(PG8_SB(1, 0), b3, voffB); PG8_STAGE(PG8_SB(1, 1), b3 + hstep, voffB); PG8_STAGE(PG8_SA(1, 0), a3, voffA);
            PG8_WAIT_V(8); PG8_WAIT_L(0); PG8_BAR; PG8_MMA(1, 0, At, B0); PG8_MMA(1, 1, At, B1); PG8_BAR; PG8_SCHED;
            } else {
            PG8_LDB(B0, 0, 0); PG8_SCHED; PG8_LDA(At, 0, 0); PG8_STAGE(PG8_SA(1, 1), a1 + hstep, voffA);
            PG8_WAIT_L(8); PG8_BAR; PG8_WAIT_L(0); PG8_MMA(0, 0, At, B0); PG8_BAR; PG8_SCHED;
            PG8_LDB(B1, 0, 1); PG8_STAGE(PG8_SB(0, 0), b2, voffB);
            PG8_BAR; PG8_WAIT_L(0); PG8_MMA(0, 1, At, B1); PG8_BAR;
            PG8_LDA(At, 0, 1); PG8_STAGE(PG8_SA(0, 0), a2, voffA);
            PG8_BAR; PG8_WAIT_L(0); PG8_MMA(1, 0, At, B0); PG8_BAR; PG8_SCHED;
            PG8_STAGE(PG8_SB(0, 1), b2 + hstep, voffB);
            PG8_WAIT_V(6); PG8_BAR; PG8_MMA(1, 1, At, B1); PG8_BAR;
            PG8_LDB(B0, 1, 0); PG8_SCHED; PG8_LDA(At, 1, 0); PG8_STAGE(PG8_SA(0, 1), a2 + hstep, voffA);
            PG8_WAIT_L(8); PG8_BAR; PG8_WAIT_L(0); PG8_MMA(0, 0, At, B0); PG8_BAR; PG8_SCHED;
            PG8_LDB(B1, 1, 1); PG8_STAGE(PG8_SB(1, 0), b3, voffB);
            PG8_BAR; PG8_WAIT_L(0); PG8_MMA(0, 1, At, B1); PG8_BAR;
            PG8_LDA(At, 1, 1); PG8_STAGE(PG8_SA(1, 0), a3, voffA);
            PG8_BAR; PG8_WAIT_L(0); PG8_MMA(1, 0, At, B0); PG8_BAR; PG8_SCHED;
            PG8_STAGE(PG8_SB(1, 1), b3 + hstep, voffB);
            PG8_WAIT_V(6); PG8_BAR; PG8_MMA(1, 1, At, B1); PG8_BAR;
            }
        }
        if constexpr (ALIGN_EPI) { if (wr == 0) PG8_BAR; }
        if constexpr (!Epi::AFTER_DRAIN) { E(acc, cur, wr, wc, fr, fq); S.done(cur); }
        if (!has_next) break;
#pragma unroll
        for (int a = 0; a < 2; ++a)
#pragma unroll
            for (int b = 0; b < 2; ++b)
#pragma unroll
                for (int m = 0; m < 4; ++m)
#pragma unroll
                    for (int n = 0; n < 2; ++n) acc[a][b][m][n] = (f32x4){0.f, 0.f, 0.f, 0.f};
        cur = nxt; cA = nA; cB = nB; ++ui;
        if constexpr (ALIGN_EPI) { if (wr == 1) PG8_BAR; }
    }
    PG8_WAIT_V(0);
    if constexpr (!ALIGN_EPI) { if (wr == 0) PG8_BAR; }
    PG8_BAR;
    if constexpr (Epi::AFTER_DRAIN) { E.fused(acc, cur, wr, wc, fr, fq, lds, wid, lane); S.done(cur); }
#undef PG8_SA
#undef PG8_SB
#undef PG8_STAGE
#undef PG8_LDA
#undef PG8_LDB
#undef PG8_MMA
#undef PG8_WAIT_V
#undef PG8_WAIT_L
#undef PG8_BAR
#undef PG8_SCHED
}
}

#ifndef PG8_SP2
#define PG8_SP2 true
#endif
#ifndef PG8_ALIGN
#define PG8_ALIGN true
#endif
#ifndef REP_MASK
#define REP_MASK 0
#endif
#ifndef REP2
#define REP2 0
#endif
#ifndef MEMFIRST
#define MEMFIRST 1
#endif
#ifndef SAMPLEFIRST
#define SAMPLEFIRST 1
#endif
#ifndef MK_ONE_LAUNCH
#define MK_ONE_LAUNCH 1
#endif

constexpr int NWAVES = 8, NTHR = 512;
constexpr int D = 1024, ROWS_P = 16384, ROWS_S = 128, ROWS_T = 16512, M_PAD = 16640, SEQ = 2048, NB = 8;
constexpr int IN_E = 3584, IN_O = 5152, IN_O_PAD = 5376, FF = 4096, MI = 2048, CONVD = 3072;
constexpr int NMODROW = 136, MODW = 6144;
constexpr float EPS = 1e-6f;
static_assert(ROWS_P == pg8::ROWS_P && ROWS_T == pg8::ROWS_T, "row constants");

constexpr size_t MiB = 1u << 20;
constexpr size_t WS_CTL = 0, CTL_ZERO_BYTES = 64 * 1024;
constexpr size_t WS_MOD = 1 * MiB;
constexpr size_t WS_WIE = 8 * MiB, WS_WOE = 15 * MiB, WS_WIO = 17 * MiB, WS_WOO = 28 * MiB, WS_W1 = 32 * MiB, WS_W2 = 48 * MiB;
constexpr size_t WS_XR = 64 * MiB;
constexpr size_t WS_H = 129 * MiB;
constexpr size_t WS_A2 = 162 * MiB;
constexpr size_t WS_Y1 = 129 * MiB;
constexpr size_t WS_BIG = 195 * MiB;
constexpr size_t WS_XBC = 366 * MiB;
constexpr size_t WS_SS = 464 * MiB;
constexpr size_t WS_DTB = 473 * MiB, WS_CSB = 476 * MiB;
constexpr size_t WS_RS = 480 * MiB;
constexpr size_t WS_SHB = 481 * MiB;
constexpr size_t WS_CB = 483 * MiB;
constexpr int CB_LD = 17152, CB_OFF0 = 0, CB_OFF1 = 3584, CB_OFF2 = 7680, CB_OFF3 = 13056;
constexpr size_t WS_H3 = WS_XBC;
constexpr size_t WS_END = 488 * MiB;
constexpr size_t WS_QB = WS_H, WS_OL = WS_H + 16 * MiB, WS_SSEG = WS_XBC, WS_DSEG = WS_XBC + 16 * MiB;
static_assert(WS_H + (size_t)M_PAD * D * 2 <= WS_A2 && WS_A2 + (size_t)M_PAD * D * 2 <= WS_BIG && WS_Y1 + (size_t)M_PAD * MI * 2 <= WS_BIG, "ws map 1");
static_assert(WS_BIG + (size_t)M_PAD * IN_O_PAD * 2 <= WS_XBC && WS_XBC + (size_t)M_PAD * CONVD * 2 <= WS_SS && WS_SS + (size_t)M_PAD * 128 * 4 <= WS_DTB && WS_DTB + (size_t)M_PAD * 32 * 4 <= WS_CSB && WS_CSB + (size_t)M_PAD * 32 * 4 <= WS_RS && WS_RS + (size_t)4 * M_PAD * 4 <= WS_SHB && WS_SHB + (size_t)4 * 192 * 1024 * 2 <= WS_CB && WS_CB + (size_t)64 * CB_LD * 4 <= WS_END, "ws map 2");
static_assert(WS_XR + (size_t)M_PAD * D * 4 <= WS_H && WS_WIO + (size_t)IN_O_PAD * D * 2 <= WS_WOO, "ws map 3");
constexpr int CW_BAR = 4096;

constexpr size_t O_Y = 0, O_HGP = 16908288, O_HGS = 17432576, O_SCP = 25821184, O_SCS = 25829376, O_SSMP = 25960448, O_SSMS = 28057600, O_MCP = 61612032, O_MCS = 61685760, O_END = 62865408;

constexpr int RING_BYTES = 131072, LDSCTL_OFF = RING_BYTES, MISC_OFF = LDSCTL_OFF + 320, YT_OFF = 133120, LDS_BYTES = 155648;

#define GAS __attribute__((address_space(1)))
#define LAS __attribute__((address_space(3)))
typedef unsigned short bf16;
typedef unsigned v4u __attribute__((ext_vector_type(4)));
typedef unsigned v2u __attribute__((ext_vector_type(2)));
typedef float f32x4 __attribute__((ext_vector_type(4)));
typedef float f32x16 __attribute__((ext_vector_type(16)));
typedef short bf16x8 __attribute__((ext_vector_type(8)));
typedef GAS unsigned gu32;
#define RLX_AGENT __ATOMIC_RELAXED, __HIP_MEMORY_SCOPE_AGENT
#define LDS_WAIT() asm volatile("s_waitcnt lgkmcnt(0)" ::: "memory")
#define VM_WAIT() asm volatile("s_waitcnt vmcnt(0)" ::: "memory")
typedef __bf16 bfv2 __attribute__((ext_vector_type(2)));
typedef float f32x2 __attribute__((ext_vector_type(2)));
__device__ __forceinline__ unsigned pk2(float lo, float hi) { const f32x2 v = {lo, hi}; return __builtin_bit_cast(unsigned, __builtin_convertvector(v, bfv2)); }
__device__ __forceinline__ unsigned f2bf(float f) { return pk2(f, 0.f) & 0xffffu; }
__device__ __forceinline__ float bf2f(unsigned h) { return __builtin_bit_cast(float, h << 16); }
__device__ __forceinline__ float bflo(unsigned w) { return __builtin_bit_cast(float, w << 16); }
__device__ __forceinline__ float bfhi(unsigned w) { return __builtin_bit_cast(float, w & 0xffff0000u); }
__device__ __forceinline__ float fexp_(float x) { return __builtin_amdgcn_exp2f(1.4426950408889634f * x); }
__device__ __forceinline__ float flog_(float x) { return 0.6931471805599453f * __builtin_amdgcn_logf(x); }
__device__ __forceinline__ float sigmoidf_(float x) { return __builtin_amdgcn_rcpf(1.f + __builtin_amdgcn_exp2f(-1.4426950408889634f * x)); }
__device__ __forceinline__ float siluf_(float x) { return x * sigmoidf_(x); }
__device__ __forceinline__ float softplusf_(float x) { return x > 15.f ? x : flog_(1.f + fexp_(x)); }
__device__ __forceinline__ float frsq_(float x) { return __builtin_amdgcn_rsqf(x); }
__device__ __forceinline__ float wave_sum(float v) {
#pragma unroll
    for (int o = 1; o < 64; o <<= 1) v += __shfl_xor(v, o);
    return v;
}

#define XB_TMO      128
#define XB_XCNT(j)  (256  + 64 * (j))
#define XB_XSUB(j)  (1280 + 64 * (j))
#define XB_XGEN(j)  (2304 + 64 * (j))
#define XB_TOP      3328
#define XB_TOPGEN   3392
#define XCD_BAR_WORDS 3456
#define XB_SPIN_CAP (1u << 18)

__device__ __forceinline__ unsigned xb_ld(unsigned* p)              { return __hip_atomic_load(p, __ATOMIC_RELAXED, __HIP_MEMORY_SCOPE_AGENT); }
__device__ __forceinline__ unsigned xb_add(unsigned* p, unsigned v) { return __hip_atomic_fetch_add(p, v, __ATOMIC_RELAXED, __HIP_MEMORY_SCOPE_AGENT); }
__device__ __forceinline__ unsigned xb_xcc_id() { return (unsigned)__builtin_amdgcn_s_getreg((3 << 11) | 20) & 0xFu; }
#define XB_SPIN(cond, bar) do { unsigned _sp = 0; while (cond) { __builtin_amdgcn_s_sleep(1); \
    if ((++_sp & 255u) == 0u) { if (xb_ld(&(bar)[XB_TMO])) break; if (_sp > XB_SPIN_CAP) { atomicAdd(&(bar)[XB_TMO], 1u); break; } } } } while (0)

struct XcdBarrier {
    unsigned* bar; unsigned x;
    volatile LAS unsigned* st;
};

__device__ __forceinline__ XcdBarrier xcd_barrier_post(unsigned* bar, volatile LAS unsigned* st) {
    XcdBarrier b; b.bar = bar; b.x = xb_xcc_id(); b.st = st;
    if (threadIdx.x == 0) (void)xb_add(&bar[XB_XCNT(b.x)], 1u);
    return b;
}
__device__ __forceinline__ void xcd_barrier_complete(unsigned* bar, unsigned x, unsigned& nloc, unsigned& nx) {
    const unsigned G = gridDim.x * gridDim.y * gridDim.z;
    unsigned sum, cnt, mine, sp = 0u;
    for (;;) {
        sum = 0u; cnt = 0u; mine = 0u;
#pragma unroll
        for (unsigned j = 0; j < 16; ++j) { const unsigned c = xb_ld(&bar[XB_XCNT(j)]); sum += c; cnt += (c > 0u) ? 1u : 0u; mine = (j == x) ? c : mine; }
        if (sum == G) break;
        __builtin_amdgcn_s_sleep(1);
        if ((++sp & 255u) == 0u) { if (xb_ld(&bar[XB_TMO])) break; if (sp > XB_SPIN_CAP) { atomicAdd(&bar[XB_TMO], 1u); break; } }
    }
    nloc = mine > 0u ? mine : 1u; nx = cnt > 0u ? cnt : 1u;
}

__device__ __forceinline__ void xcd_barrier(const XcdBarrier& b) {
    asm volatile("s_waitcnt vmcnt(0)" ::: "memory");
    __syncthreads();
    if (threadIdx.x == 0) {
        unsigned* bar = b.bar;
        __builtin_amdgcn_s_waitcnt(0);
        unsigned nloc = b.st[0], nx = b.st[1];
        if (nloc == 0u) { xcd_barrier_complete(bar, b.x, nloc, nx); b.st[0] = nloc; b.st[1] = nx; }
        const unsigned old = xb_add(&bar[XB_XSUB(b.x)], 1u);
        const unsigned gen = old / nloc;
        if (old + 1u == (gen + 1u) * nloc) {
            __builtin_amdgcn_fence(__ATOMIC_RELEASE, "agent");
            asm volatile("s_waitcnt vmcnt(0)" ::: "memory");
            const unsigned og = xb_add(&bar[XB_TOP], 1u);
            const unsigned tg = og / nx;
            if (og + 1u == (tg + 1u) * nx) xb_add(&bar[XB_TOPGEN], 1u);
            else XB_SPIN(xb_ld(&bar[XB_TOPGEN]) == tg, bar);
            __builtin_amdgcn_fence(__ATOMIC_ACQUIRE, "agent");
            xb_add(&bar[XB_XGEN(b.x)], 1u);
            asm volatile("s_waitcnt vmcnt(0)" ::: "memory");
        } else {
            XB_SPIN(xb_ld(&bar[XB_XGEN(b.x)]) == gen, bar);
            __builtin_amdgcn_fence(__ATOMIC_ACQUIRE, "agent");
            asm volatile("s_waitcnt vmcnt(0)" ::: "memory");
        }
    }
    __syncthreads();
}

struct Args { const float* in[28]; float* out; unsigned char* ws; int ph_lo, ph_hi; };
struct Ctx {
    LAS unsigned char* lds; int tid, lane, wave, G, vcu, bid;
    const float* const* in; float* out; unsigned char* ws;
};
enum { I_XP = 0, I_XS, I_CP, I_CS, I_SHG, I_SSC, I_SSSM, I_SMC, I_ADAW, I_ADAB, I_NMIX, I_NMLP, I_NFIN, I_WIE, I_HLB, I_HGN, I_SCW, I_WOE, I_WIO, I_MCW, I_MCB, I_DTB, I_ALOG, I_DSK, I_MNORM, I_WOO, I_W1, I_W2 };

__device__ __forceinline__ void p0_transpose_item(const float* W, int K, int N, bf16* WT, LAS float* scr, int item, int lane) {
    const int nblk = N / 32, kb = item / nblk, nb = item % nblk, k0 = 64 * kb, n0 = 32 * nb;
    f32x4 v[8];
#pragma unroll
    for (int i = 0; i < 8; ++i) v[i] = *(const GAS f32x4*)(W + (size_t)(k0 + 8 * i + (lane >> 3)) * N + n0 + 4 * (lane & 7));
#pragma unroll
    for (int i = 0; i < 8; ++i) { LAS float* d = scr + (8 * i + (lane >> 3)) * 33 + 4 * (lane & 7); d[0] = v[i].x; d[1] = v[i].y; d[2] = v[i].z; d[3] = v[i].w; }
    LDS_WAIT(); asm volatile("" ::: "memory");
    const int c = lane & 7;
#pragma unroll
    for (int j = 0; j < 4; ++j) { const int n = (lane >> 3) + 8 * j; const LAS float* s = scr + (8 * c) * 33 + n;
        v4u o; o.x = pk2(s[0 * 33], s[1 * 33]); o.y = pk2(s[2 * 33], s[3 * 33]); o.z = pk2(s[4 * 33], s[5 * 33]); o.w = pk2(s[6 * 33], s[7 * 33]);
        *(GAS v4u*)(WT + (size_t)(n0 + n) * K + k0 + 8 * c) = o; }
    LDS_WAIT(); asm volatile("" ::: "memory");
}
__device__ __forceinline__ bf16x8 pack8(const float (&v)[8]) { v4u o; o.x = pk2(v[0], v[1]); o.y = pk2(v[2], v[3]); o.z = pk2(v[4], v[5]); o.w = pk2(v[6], v[7]); return __builtin_bit_cast(bf16x8, o); }

__device__ __forceinline__ void p0_phase(const Ctx& F) {
    float* mod = (float*)(F.ws + WS_MOD);
    for (int task = F.bid; task < 384; task += F.G) {
        const int l = task / 192, n0 = (task % 192) * 32;
        const float* W = F.in[I_ADAW] + (size_t)l * 1024 * 6144;
        f32x16 acc[5];
#pragma unroll
        for (int rt = 0; rt < 5; ++rt)
#pragma unroll
            for (int e = 0; e < 16; ++e) acc[rt][e] = 0.f;
        const int r = F.lane & 31, h = F.lane >> 5;
        float wn[8];
#pragma unroll
        for (int j = 0; j < 8; ++j) wn[j] = W[(size_t)(F.wave * 128 + 8 * h + j) * 6144 + n0 + r];
        for (int ks = 0; ks < 8; ++ks) {
            const int kb = F.wave * 128 + ks * 16 + 8 * h;
            const bf16x8 bfrag = pack8(wn);
            if (ks + 1 < 8) {
#pragma unroll
                for (int j = 0; j < 8; ++j) wn[j] = W[(size_t)(kb + 16 + j) * 6144 + n0 + r]; }
#pragma unroll
            for (int rt = 0; rt < 5; ++rt) {
                const int row = rt * 32 + r; float cv[8];
                if (row < NMODROW) {
                    const float* cp = row < 8 ? F.in[I_CP] + (size_t)row * 1024 : F.in[I_CS] + (size_t)(row - 8) * 1024;
                    const f32x4 a = *(const f32x4*)(cp + kb), b = *(const f32x4*)(cp + kb + 4);
#pragma unroll
                    for (int e = 0; e < 4; ++e) { cv[e] = siluf_(a[e]); cv[4 + e] = siluf_(b[e]); }
                } else {
#pragma unroll
                    for (int e = 0; e < 8; ++e) cv[e] = 0.f;
                }
                acc[rt] = __builtin_amdgcn_mfma_f32_32x32x16_bf16(pack8(cv), bfrag, acc[rt], 0, 0, 0);
            }
        }
        LAS float* red = (LAS float*)F.lds;
#pragma unroll
        for (int rt = 0; rt < 5; ++rt) {
#pragma unroll
            for (int e = 0; e < 16; ++e) red[(F.wave * 16 + e) * 64 + F.lane] = acc[rt][e];
            __syncthreads();
            for (int s = F.tid; s < 1024; s += NTHR) {
                float sum = 0.f;
#pragma unroll
                for (int w = 0; w < 8; ++w) sum += red[w * 1024 + s];
                const int reg = s >> 6, ln = s & 63; const int row = rt * 32 + (reg & 3) + 8 * (reg >> 2) + 4 * (ln >> 5); const int n = n0 + (ln & 31);
                if (row < NMODROW) { const float val = sum + F.in[I_ADAB][l * MODW + n]; mod[((size_t)l * NMODROW + row) * MODW + n] = val;
                    const int chunk = n >> 10; if (chunk == 0 || chunk == 3) ((bf16*)(F.ws + WS_SHB))[((size_t)(l * 2 + (chunk == 3)) * 192 + row) * 1024 + (n & 1023)] = (bf16)f2bf(val); }
            }
            __syncthreads();
        }
    }
    __syncthreads();
    LAS float* scr = (LAS float*)(F.lds + F.wave * 16384);
    const int gw = F.vcu * NWAVES + F.wave, NGW = F.G * NWAVES;
    constexpr int I0 = 16 * 112, I1 = 16 * 32, I2 = 16 * 161, I3 = 32 * 32, I4 = 16 * 128, I5 = 64 * 32;
    constexpr int NITEMS = I0 + I1 + I2 + I3 + 2 * I4 + 2 * I5;
    const bool split = (F.G == 256); constexpr int NPASS1 = 5 * 2048;
    for (int pass = 0; pass < 2; ++pass) {
    int it0, istep, iend;
    if (!split) { if (pass) break; it0 = gw; istep = NGW; iend = NITEMS; }
    else if (pass == 0) { it0 = gw; istep = NGW; iend = NPASS1; }
    else { if (F.bid < 128) break; it0 = NPASS1 + (F.bid - 128) * NWAVES + F.wave; istep = 128 * NWAVES; iend = NITEMS; }
    for (int it = it0; it < iend; it += istep) {
        int r = it;
        if (r < I0) { p0_transpose_item(F.in[I_WIE], 1024, IN_E, (bf16*)(F.ws + WS_WIE), scr, r, F.lane); continue; } r -= I0;
        if (r < I1) { p0_transpose_item(F.in[I_WOE], 1024, 1024, (bf16*)(F.ws + WS_WOE), scr, r, F.lane); continue; } r -= I1;
        if (r < I2) { p0_transpose_item(F.in[I_WIO], 1024, IN_O, (bf16*)(F.ws + WS_WIO), scr, r, F.lane); continue; } r -= I2;
        if (r < I3) { p0_transpose_item(F.in[I_WOO], 2048, 1024, (bf16*)(F.ws + WS_WOO), scr, r, F.lane); continue; } r -= I3;
        if (r < 2 * I4) { const int l = r / I4; p0_transpose_item(F.in[I_W1] + (size_t)l * 1024 * FF, 1024, FF, (bf16*)(F.ws + WS_W1 + l * 8 * MiB), scr, r % I4, F.lane); continue; } r -= 2 * I4;
        { const int l = r / I5; p0_transpose_item(F.in[I_W2] + (size_t)l * FF * 1024, FF, 1024, (bf16*)(F.ws + WS_W2 + l * 8 * MiB), scr, r % I5, F.lane); }
    }
    }
    { GAS v4u* z = (GAS v4u*)(F.ws + WS_RS); const int n16 = 4 * M_PAD * 4 / 16;
      for (int i = F.bid * NTHR + F.tid; i < n16; i += F.G * NTHR) z[i] = (v4u){0u, 0u, 0u, 0u}; }
    { GAS v4u* z = (GAS v4u*)(F.ws + WS_WIO + (size_t)IN_O * 1024 * 2); const int n16 = (IN_O_PAD - IN_O) * 1024 * 2 / 16;
      for (int i = F.bid * NTHR + F.tid; i < n16; i += F.G * NTHR) z[i] = (v4u){0u, 0u, 0u, 0u}; }
}

template <int NR> __device__ __forceinline__ void norm_rows(const Ctx& F, size_t hoff, int rowb, const float* xp, const float* xs, const f32x4 (&g4)[4], const float* mod_sh, const float* mod_s) {
    bf16* H = (bf16*)(F.ws + hoff);
    f32x4 v[NR][4];
#pragma unroll
    for (int r = 0; r < NR; ++r) { const int row = rowb + r;
        if (row < ROWS_T) { const float* xr = row < ROWS_P ? xp + (size_t)row * D : xs + (size_t)(row - ROWS_P) * D; const GAS f32x4* x4 = (const GAS f32x4*)xr + F.lane;
#pragma unroll
            for (int j = 0; j < 4; ++j) v[r][j] = x4[64 * j]; }
        else {
#pragma unroll
            for (int j = 0; j < 4; ++j) v[r][j] = (f32x4){0.f, 0.f, 0.f, 0.f}; } }
#pragma unroll
    for (int r = 0; r < NR; ++r) { const int row = rowb + r;
        GAS v2u* o = (GAS v2u*)(H + (size_t)row * D) + F.lane;
        if (row >= ROWS_T) {
#pragma unroll
            for (int j = 0; j < 4; ++j) o[64 * j] = (v2u){0u, 0u};
            continue; }
        const int mr = pg8::mod_row(row); float ss = 0.f;
#pragma unroll
        for (int j = 0; j < 4; ++j) ss += (v[r][j].x * v[r][j].x + v[r][j].y * v[r][j].y) + (v[r][j].z * v[r][j].z + v[r][j].w * v[r][j].w);
        const float rstd = frsq_(wave_sum(ss) * (1.f / D) + EPS);
#pragma unroll
        for (int j = 0; j < 4; ++j) { const int c = 4 * (F.lane + 64 * j);
            const f32x4 s4 = *(const f32x4*)(mod_s + (size_t)mr * MODW + c), h4 = *(const f32x4*)(mod_sh + (size_t)mr * MODW + c);
            const f32x4 y = v[r][j] * rstd * g4[j] * (s4 + 1.f) + h4;
            o[64 * j] = (v2u){pk2(y.x, y.y), pk2(y.z, y.w)}; }
    }
}
__device__ __forceinline__ void norm_sample_phase(const Ctx& F, size_t hoff, const float* xs, const float* g, const float* mod_sh, const float* mod_s) {
    const int gw = F.vcu * NWAVES + F.wave, NGW = F.G * NWAVES;
    f32x4 g4[4];
#pragma unroll
    for (int j = 0; j < 4; ++j) g4[j] = *(const f32x4*)(g + 4 * (F.lane + 64 * j));
    for (int row = ROWS_P + gw; row < M_PAD; row += NGW) norm_rows<1>(F, hoff, row, xs, xs, g4, mod_sh, mod_s);
}
template <int NR> __device__ __forceinline__ void xg_rows(const Ctx& F, int rowb, const float* xp, const f32x4 (&g4)[4], const float* mod_s) {
    bf16* H = (bf16*)(F.ws + WS_H); float* RS = (float*)(F.ws + WS_RS);
    f32x4 v[NR][4];
#pragma unroll
    for (int r = 0; r < NR; ++r) { const GAS f32x4* x4 = (const GAS f32x4*)(xp + (size_t)(rowb + r) * D) + F.lane;
#pragma unroll
        for (int j = 0; j < 4; ++j) v[r][j] = x4[64 * j]; }
#pragma unroll
    for (int r = 0; r < NR; ++r) { const int row = rowb + r; GAS v2u* o = (GAS v2u*)(H + (size_t)row * D) + F.lane; float ss = 0.f;
#pragma unroll
        for (int j = 0; j < 4; ++j) ss += (v[r][j].x * v[r][j].x + v[r][j].y * v[r][j].y) + (v[r][j].z * v[r][j].z + v[r][j].w * v[r][j].w);
        ss = wave_sum(ss); if (F.lane == 0) RS[row] = ss;
        const int mr = row >> 11;
#pragma unroll
        for (int j = 0; j < 4; ++j) { const int c = 4 * (F.lane + 64 * j);
            const f32x4 s4 = *(const f32x4*)(mod_s + (size_t)mr * MODW + c);
            const f32x4 y = v[r][j] * g4[j] * (s4 + 1.f);
            o[64 * j] = (v2u){pk2(y.x, y.y), pk2(y.z, y.w)}; }
    }
}
__device__ __forceinline__ void xg_phase(const Ctx& F, const float* xp, const float* xs, const float* g, const float* mod_sh, const float* mod_s) {
    const int gw = F.vcu * NWAVES + F.wave, NGW = F.G * NWAVES;
    f32x4 g4[4];
#pragma unroll
    for (int j = 0; j < 4; ++j) g4[j] = *(const f32x4*)(g + 4 * (F.lane + 64 * j));
    for (int rowb = gw * 4; rowb < ROWS_P; rowb += NGW * 4) xg_rows<4>(F, rowb, xp, g4, mod_s);
    for (int row = ROWS_P + gw; row < M_PAD; row += NGW) norm_rows<1>(F, WS_H, row, xs, xs, g4, mod_sh, mod_s);
}
template <int NR, bool BF> __device__ __forceinline__ void final_rows(const Ctx& F, int rowb, const f32x4 (&g4)[4]) {
    const float* XR = (const float*)(F.ws + WS_XR); const bf16* XRb = (const bf16*)(F.ws + WS_XR);
    f32x4 v[NR][4];
#pragma unroll
    for (int r = 0; r < NR; ++r) {
        if (BF) { const GAS v2u* x2 = (const GAS v2u*)(XRb + (size_t)(rowb + r) * D) + F.lane;
#pragma unroll
            for (int j = 0; j < 4; ++j) { const v2u w = x2[64 * j]; v[r][j] = (f32x4){bflo(w.x), bfhi(w.x), bflo(w.y), bfhi(w.y)}; } }
        else { const GAS f32x4* x4 = (const GAS f32x4*)(XR + (size_t)(rowb + r) * D) + F.lane;
#pragma unroll
            for (int j = 0; j < 4; ++j) v[r][j] = x4[64 * j]; } }
#pragma unroll
    for (int r = 0; r < NR; ++r) { GAS f32x4* o = (GAS f32x4*)(F.out + O_Y + (size_t)(rowb + r) * D) + F.lane; float ss = 0.f;
#pragma unroll
        for (int j = 0; j < 4; ++j) ss += (v[r][j].x * v[r][j].x + v[r][j].y * v[r][j].y) + (v[r][j].z * v[r][j].z + v[r][j].w * v[r][j].w);
        const float rstd = frsq_(wave_sum(ss) * (1.f / D) + EPS);
#pragma unroll
        for (int j = 0; j < 4; ++j) o[64 * j] = v[r][j] * rstd * g4[j]; }
}
__device__ __forceinline__ void final_phase(const Ctx& F) {
    const float* g = F.in[I_NFIN];
    const int gw = F.vcu * NWAVES + F.wave, NGW = F.G * NWAVES;
    f32x4 g4[4];
#pragma unroll
    for (int j = 0; j < 4; ++j) g4[j] = *(const f32x4*)(g + 4 * (F.lane + 64 * j));
    for (int rowb = gw * 4; rowb < ROWS_P; rowb += NGW * 4) final_rows<4, true>(F, rowb, g4);
    for (int row = ROWS_P + gw; row < ROWS_T; row += NGW) final_rows<1, false>(F, row, g4);
}

__device__ __forceinline__ float hgrn_lb(const Ctx& F, int c) { const float* hl = F.in[I_HLB]; return sigmoidf_(hl[512 + c] - hl[c]); }

template <int CTRL> __device__ __forceinline__ float dppf(float x) { return __builtin_bit_cast(float, __builtin_amdgcn_update_dpp(0, __builtin_bit_cast(int, x), CTRL, 0xF, 0xF, false)); }
__device__ __forceinline__ float red16(float x) {
    x += dppf<0xB1>(x); x += dppf<0x4E>(x); x += dppf<0x124>(x); x += dppf<0x128>(x); return x;
}
__device__ __forceinline__ void unpack8(const v4u a, float (&f)[8]) {
#pragma unroll
    for (int e = 0; e < 4; ++e) { f[2 * e] = bflo(a[e]); f[2 * e + 1] = bfhi(a[e]); }
}
typedef short s16x4 __attribute__((ext_vector_type(4)));
__device__ __forceinline__ bf16x8 tr16_pair(LAS unsigned char* p0, LAS unsigned char* p1) {
    const s16x4 a = __builtin_amdgcn_ds_read_tr16_b64_v4i16((LAS s16x4*)p0), b = __builtin_amdgcn_ds_read_tr16_b64_v4i16((LAS s16x4*)p1);
    return __builtin_shufflevector(a, b, 0, 1, 2, 3, 4, 5, 6, 7);
}
__device__ __forceinline__ bf16x8 cat64(v2u a, v2u b) { return __builtin_bit_cast(bf16x8, (v4u){a.x, a.y, b.x, b.y}); }
__device__ __forceinline__ bf16x8 acc_pair_bf16(f32x4 a, f32x4 b) { return __builtin_bit_cast(bf16x8, (v4u){pk2(a[0], a[1]), pk2(a[2], a[3]), pk2(b[0], b[1]), pk2(b[2], b[3])}); }
#define MFMA16(a, b, c) __builtin_amdgcn_mfma_f32_16x16x32_bf16((a), (b), (c), 0, 0, 0)

__device__ __forceinline__ void mix0_gla_seg(const Ctx& F, int unit) {
    const int seg = unit & 7, h = (unit >> 3) & 3, b = unit >> 5;
    bf16* QB = (bf16*)(F.ws + WS_QB); bf16* OL = (bf16*)(F.ws + WS_OL); float* SSEG = (float*)(F.ws + WS_SSEG); float* DSEG = (float*)(F.ws + WS_DSEG);
    const bf16* PROJ = (const bf16*)(F.ws + WS_BIG);
    constexpr int RS1 = 272, RSA = 80;
    constexpr int OFF_QD = 0, OFF_KD = 8704, OFF_KT = 17408, OFF_V = 26112, OFF_ATT = 34816, OFF_LF = 37376, OFF_PS = 53760, OFF_DEC = 55808, OFF_SSQ = 56320, OFF_OT = 57344;
    LAS unsigned char* L = F.lds;
    LAS float* LF = (LAS float*)(L + OFF_LF); LAS float* PS = (LAS float*)(L + OFF_PS); LAS float* DEC = (LAS float*)(L + OFF_DEC); LAS float* SSQ = (LAS float*)(L + OFF_SSQ);
    const int tid = F.tid, lane = F.lane, w = F.wave, g = lane >> 4, r15 = lane & 15, qq = r15 >> 2, pp = lane & 3;
    const int j1 = tid >> 4, ko = tid & 15;
    const int k2 = tid & 127, part = tid >> 7;
    float lbv[8];
#pragma unroll
    for (int e = 0; e < 8; ++e) lbv[e] = hgrn_lb(F, h * 128 + 8 * ko + e);
    float bc[8];
#pragma unroll
    for (int e = 0; e < 8; ++e) bc[e] = 0.f;
    f32x4 st[8];
#pragma unroll
    for (int i = 0; i < 8; ++i) st[i] = (f32x4){0.f, 0.f, 0.f, 0.f};
    const bf16* prow = PROJ + (size_t)(b * SEQ + seg * 256 + j1) * IN_E + h * 128 + 8 * ko;
    v4u q8 = *(const GAS v4u*)prow, z8 = *(const GAS v4u*)(prow + 512), i8 = *(const GAS v4u*)(prow + 1024);
    for (int c = 0; c < 8; ++c) {
        const int row0 = b * SEQ + seg * 256 + c * 32;
        float qf[8], kf[8];
        { float lf[8];
#pragma unroll
          for (int e = 0; e < 4; ++e) {
              qf[2 * e] = bflo(q8[e]); qf[2 * e + 1] = bfhi(q8[e]);
              const float f0 = lbv[2 * e] + (1.f - lbv[2 * e]) * sigmoidf_(bflo(z8[e])), f1 = lbv[2 * e + 1] + (1.f - lbv[2 * e + 1]) * sigmoidf_(bfhi(z8[e]));
              kf[2 * e] = 1.f - f0; kf[2 * e + 1] = 1.f - f1; lf[2 * e] = __logf(f0); lf[2 * e + 1] = __logf(f1); }
          *(LAS f32x4*)&LF[j1 * 128 + 8 * ko] = (f32x4){lf[0], lf[1], lf[2], lf[3]}; *(LAS f32x4*)&LF[j1 * 128 + 8 * ko + 4] = (f32x4){lf[4], lf[5], lf[6], lf[7]};
          *(LAS v4u*)(L + OFF_V + j1 * RS1 + 16 * ko) = i8; }
        if (c + 1 < 8) { prow += (size_t)32 * IN_E; q8 = *(const GAS v4u*)prow; z8 = *(const GAS v4u*)(prow + 512); i8 = *(const GAS v4u*)(prow + 1024); }
        __syncthreads();
        { float x[8];
#pragma unroll
          for (int e = 0; e < 8; ++e) x[e] = LF[(8 * part + e) * 128 + k2];
#pragma unroll
          for (int e = 1; e < 8; ++e) x[e] += x[e - 1];
#pragma unroll
          for (int e = 0; e < 8; ++e) LF[(8 * part + e) * 128 + k2] = x[e];
          PS[part * 128 + k2] = x[7]; }
        __syncthreads();
        { const int pj = j1 >> 3;
          f32x4 o0 = (f32x4){0.f, 0.f, 0.f, 0.f}, o1 = o0, t0 = o0, t1 = o0;
#pragma unroll
          for (int p = 0; p < 3; ++p) { const f32x4 a = *(const LAS f32x4*)&PS[p * 128 + 8 * ko], bb = *(const LAS f32x4*)&PS[p * 128 + 8 * ko + 4];
              t0 += a; t1 += bb; if (p < pj) { o0 += a; o1 += bb; } }
          const f32x4 b0 = *(const LAS f32x4*)&LF[j1 * 128 + 8 * ko] + o0, b1 = *(const LAS f32x4*)&LF[j1 * 128 + 8 * ko + 4] + o1;
          const f32x4 l0 = *(const LAS f32x4*)&LF[31 * 128 + 8 * ko] + t0, l1 = *(const LAS f32x4*)&LF[31 * 128 + 8 * ko + 4] + t1;
          float qd[8], kd[8], kt[8];
#pragma unroll
          for (int e = 0; e < 8; ++e) { const float bv = e < 4 ? b0[e & 3] : b1[e & 3], lv = e < 4 ? l0[e & 3] : l1[e & 3];
              qd[e] = qf[e] * __expf(bv); kd[e] = kf[e] * __expf(-bv); kt[e] = kf[e] * __expf(lv - bv); }
          *(LAS v4u*)(L + OFF_QD + j1 * RS1 + 16 * ko) = (v4u){pk2(qd[0], qd[1]), pk2(qd[2], qd[3]), pk2(qd[4], qd[5]), pk2(qd[6], qd[7])};
          *(LAS v4u*)(L + OFF_KD + j1 * RS1 + 16 * ko) = (v4u){pk2(kd[0], kd[1]), pk2(kd[2], kd[3]), pk2(kd[4], kd[5]), pk2(kd[6], kd[7])};
          *(LAS v4u*)(L + OFF_KT + j1 * RS1 + 16 * ko) = (v4u){pk2(kt[0], kt[1]), pk2(kt[2], kt[3]), pk2(kt[4], kt[5]), pk2(kt[6], kt[7])};
          { float qb[8];
#pragma unroll
            for (int e = 0; e < 8; ++e) qb[e] = qd[e] * fexp_(bc[e]);
            *(GAS v4u*)(QB + (size_t)(row0 + j1) * 512 + h * 128 + 8 * ko) = (v4u){pk2(qb[0], qb[1]), pk2(qb[2], qb[3]), pk2(qb[4], qb[5]), pk2(qb[6], qb[7])};
#pragma unroll
            for (int e = 0; e < 8; ++e) bc[e] += (e < 4 ? l0[e & 3] : l1[e & 3]); }
          if (j1 == 0) { *(LAS f32x4*)&DEC[8 * ko] = (f32x4){__expf(l0[0]), __expf(l0[1]), __expf(l0[2]), __expf(l0[3])}; *(LAS f32x4*)&DEC[8 * ko + 4] = (f32x4){__expf(l1[0]), __expf(l1[1]), __expf(l1[2]), __expf(l1[3])}; } }
        __syncthreads();
        if (w < 4) {
            const int it = w >> 1, jt = w & 1; f32x4 a4 = (f32x4){0.f, 0.f, 0.f, 0.f};
            if (jt <= it) {
#pragma unroll
                for (int ks = 0; ks < 4; ++ks) {
                    const bf16x8 a = *(const LAS bf16x8*)(L + OFF_QD + (16 * it + r15) * RS1 + (32 * ks + 8 * g) * 2), bb = *(const LAS bf16x8*)(L + OFF_KD + (16 * jt + r15) * RS1 + (32 * ks + 8 * g) * 2);
                    a4 = MFMA16(a, bb, a4); } }
#pragma unroll
            for (int reg = 0; reg < 4; ++reg) { const int i = 16 * it + 4 * g + reg, j = 16 * jt + r15;
                *(LAS bf16*)(L + OFF_ATT + i * RSA + 2 * j) = (bf16)f2bf(j <= i ? a4[reg] : 0.f); }
        }
        f32x4 acc_o[2] = {(f32x4){0.f, 0.f, 0.f, 0.f}, (f32x4){0.f, 0.f, 0.f, 0.f}};
#pragma unroll
        for (int ks = 0; ks < 4; ++ks) {
            const bf16x8 bfrag = acc_pair_bf16(st[2 * ks], st[2 * ks + 1]);
#pragma unroll
            for (int it = 0; it < 2; ++it) {
                const v2u a0 = *(const LAS v2u*)(L + OFF_QD + (16 * it + r15) * RS1 + (32 * ks + 4 * g) * 2), a1 = *(const LAS v2u*)(L + OFF_QD + (16 * it + r15) * RS1 + (32 * ks + 16 + 4 * g) * 2);
                acc_o[it] = MFMA16(cat64(a0, a1), bfrag, acc_o[it]); } }
        __syncthreads();
        const bf16x8 vfrag = tr16_pair(L + OFF_V + (8 * g + qq) * RS1 + (16 * w + 4 * pp) * 2, L + OFF_V + (8 * g + 4 + qq) * RS1 + (16 * w + 4 * pp) * 2);
#pragma unroll
        for (int it = 0; it < 2; ++it) { const bf16x8 a = *(const LAS bf16x8*)(L + OFF_ATT + (16 * it + r15) * RSA + 16 * g); acc_o[it] = MFMA16(a, vfrag, acc_o[it]); }
#pragma unroll
        for (int kt8 = 0; kt8 < 8; ++kt8) {
            const bf16x8 a = tr16_pair(L + OFF_KT + (8 * g + qq) * RS1 + (16 * kt8 + 4 * pp) * 2, L + OFF_KT + (8 * g + 4 + qq) * RS1 + (16 * kt8 + 4 * pp) * 2);
            const f32x4 d4 = *(const LAS f32x4*)&DEC[16 * kt8 + 4 * g];
            st[kt8] = MFMA16(a, vfrag, st[kt8] * d4); }
#pragma unroll
        for (int it = 0; it < 2; ++it)
#pragma unroll
            for (int reg = 0; reg < 4; ++reg) *(LAS bf16*)(L + OFF_OT + (16 * it + 4 * g + reg) * RS1 + (16 * w + r15) * 2) = (bf16)f2bf(acc_o[it][reg]);
        __syncthreads();
        *(GAS v4u*)(OL + (size_t)(row0 + j1) * 512 + h * 128 + 8 * ko) = *(const LAS v4u*)(L + OFF_OT + j1 * RS1 + 16 * ko);
    }
    if (j1 == 0) { *(GAS f32x4*)(DSEG + unit * 128 + 8 * ko) = (f32x4){fexp_(bc[0]), fexp_(bc[1]), fexp_(bc[2]), fexp_(bc[3])}; *(GAS f32x4*)(DSEG + unit * 128 + 8 * ko + 4) = (f32x4){fexp_(bc[4]), fexp_(bc[5]), fexp_(bc[6]), fexp_(bc[7])}; }
#pragma unroll
    for (int kt8 = 0; kt8 < 8; ++kt8) *(GAS f32x4*)(SSEG + (size_t)unit * 16384 + ((w * 8 + kt8) * 64 + lane) * 4) = st[kt8];
    __syncthreads();
}

__device__ __forceinline__ void mix0_gla_fix(const Ctx& F, int unit) {
    const int seg = unit & 7, h = (unit >> 3) & 3, b = unit >> 5;
    const bf16* PROJ = (const bf16*)(F.ws + WS_BIG); bf16* A2 = (bf16*)(F.ws + WS_A2);
    const bf16* QB = (const bf16*)(F.ws + WS_QB); const bf16* OL = (const bf16*)(F.ws + WS_OL); const float* SSEG = (const float*)(F.ws + WS_SSEG); const float* DSEG = (const float*)(F.ws + WS_DSEG);
    constexpr int RS1 = 272, RSO = 528; constexpr int OFF_QD = 0, OFF_O32 = 8704;
    LAS unsigned char* L = F.lds;
    const int tid = F.tid, lane = F.lane, w = F.wave, g = lane >> 4, r15 = lane & 15;
    const int j1 = tid >> 4, ko = tid & 15;
    float gn8[8];
#pragma unroll
    for (int e = 0; e < 8; ++e) gn8[e] = F.in[I_HGN][8 * ko + e];
    const size_t rowj = (size_t)(b * SEQ + seg * 256 + j1);
    const bf16* qrow = QB + rowj * 512 + h * 128 + 8 * ko; const bf16* orow = OL + rowj * 512 + h * 128 + 8 * ko; const bf16* grow = PROJ + rowj * IN_E + 1536 + h * 128 + 8 * ko;
    v4u q8 = *(const GAS v4u*)qrow, o8 = *(const GAS v4u*)orow, g8 = *(const GAS v4u*)grow;
    f32x4 st[8];
#pragma unroll
    for (int i = 0; i < 8; ++i) st[i] = (f32x4){0.f, 0.f, 0.f, 0.f};
    for (int sp = 0; sp < seg; ++sp) {
        const float* ss = SSEG + (size_t)(unit - seg + sp) * 16384 + (size_t)(w * 8 * 64 + lane) * 4; const float* dd = DSEG + (unit - seg + sp) * 128;
        f32x4 sv[8];
#pragma unroll
        for (int kt8 = 0; kt8 < 8; ++kt8) sv[kt8] = *(const GAS f32x4*)(ss + kt8 * 256);
#pragma unroll
        for (int kt8 = 0; kt8 < 8; ++kt8) { const f32x4 d4 = *(const f32x4*)(dd + 16 * kt8 + 4 * g); st[kt8] = st[kt8] * d4 + sv[kt8]; }
    }
    if (seg == 7) {
        float* hgp = F.out + O_HGP + (size_t)((b * 4 + h) * 128) * 128;
        const float* ss = SSEG + (size_t)unit * 16384 + (size_t)(w * 8 * 64 + lane) * 4; const float* dd = DSEG + unit * 128;
#pragma unroll
        for (int kt8 = 0; kt8 < 8; ++kt8) { const f32x4 d4 = *(const f32x4*)(dd + 16 * kt8 + 4 * g); const f32x4 fin = st[kt8] * d4 + *(const GAS f32x4*)(ss + kt8 * 256);
#pragma unroll
            for (int reg = 0; reg < 4; ++reg) hgp[(size_t)(16 * kt8 + 4 * g + reg) * 128 + 16 * w + r15] = fin[reg]; }
    }
    bf16x8 bfr[4];
#pragma unroll
    for (int ks = 0; ks < 4; ++ks) bfr[ks] = acc_pair_bf16(st[2 * ks], st[2 * ks + 1]);
    for (int c = 0; c < 8; ++c) {
        const size_t row = rowj + (size_t)c * 32;
        *(LAS v4u*)(L + OFF_QD + j1 * RS1 + 16 * ko) = q8;
        const v4u oc = o8, gc = g8;
        if (c + 1 < 8) { qrow += (size_t)32 * 512; orow += (size_t)32 * 512; grow += (size_t)32 * IN_E; q8 = *(const GAS v4u*)qrow; o8 = *(const GAS v4u*)orow; g8 = *(const GAS v4u*)grow; }
        __syncthreads();
        f32x4 acc_o[2] = {(f32x4){0.f, 0.f, 0.f, 0.f}, (f32x4){0.f, 0.f, 0.f, 0.f}};
#pragma unroll
        for (int ks = 0; ks < 4; ++ks)
#pragma unroll
            for (int it = 0; it < 2; ++it) {
                const v2u a0 = *(const LAS v2u*)(L + OFF_QD + (16 * it + r15) * RS1 + (32 * ks + 4 * g) * 2), a1 = *(const LAS v2u*)(L + OFF_QD + (16 * it + r15) * RS1 + (32 * ks + 16 + 4 * g) * 2);
                acc_o[it] = MFMA16(cat64(a0, a1), bfr[ks], acc_o[it]); }
#pragma unroll
        for (int it = 0; it < 2; ++it)
#pragma unroll
            for (int reg = 0; reg < 4; ++reg) *(LAS float*)(L + OFF_O32 + (16 * it + 4 * g + reg) * RSO + (16 * w + r15) * 4) = acc_o[it][reg];
        __syncthreads();
        { const f32x4 c0 = *(const LAS f32x4*)(L + OFF_O32 + j1 * RSO + 32 * ko), c1 = *(const LAS f32x4*)(L + OFF_O32 + j1 * RSO + 32 * ko + 16);
          float o[8], gt[8];
          unpack8(oc, o); unpack8(gc, gt);
#pragma unroll
          for (int e = 0; e < 4; ++e) { o[e] += c0[e]; o[4 + e] += c1[e]; }
          float ss = 0.f;
#pragma unroll
          for (int e = 0; e < 8; ++e) ss += o[e] * o[e];
          const float rstd = frsq_(red16(ss) * (1.f / 128.f) + EPS);
          float y[8];
#pragma unroll
          for (int e = 0; e < 8; ++e) y[e] = o[e] * rstd * gn8[e] * siluf_(gt[e]);
          *(GAS v4u*)(A2 + row * D + h * 128 + 8 * ko) = (v4u){pk2(y[0], y[1]), pk2(y[2], y[3]), pk2(y[4], y[5]), pk2(y[6], y[7])}; }
    }
    __syncthreads();
}

__device__ __forceinline__ void mix0_gla_sample(const Ctx& F, int bs, int h) {
    const bf16* PROJ = (const bf16*)(F.ws + WS_BIG); bf16* A2 = (bf16*)(F.ws + WS_A2);
    LAS float* qs = (LAS float*)F.lds; LAS float* fs = qs + 128; LAS float* ssum = qs + 256; LAS float* red = qs + 512;
    const int v4 = F.tid & 31, kq = F.tid >> 5, row = ROWS_P + bs;
    const bf16* pr = PROJ + (size_t)row * IN_E + h * 128;
    const size_t base = (size_t)((bs * 4 + h) * 128) * 128;
    const float* s0p = F.in[I_SHG] + base + (size_t)(8 * kq) * 128 + 4 * v4; float* s1p = F.out + O_HGS + base + (size_t)(8 * kq) * 128 + 4 * v4;
    f32x4 s0[8];
#pragma unroll
    for (int kk = 0; kk < 8; ++kk) s0[kk] = *(const f32x4*)(s0p + (size_t)kk * 128);
    if (F.tid < 128) { const float lb = hgrn_lb(F, h * 128 + F.tid); qs[F.tid] = bf2f(pr[F.tid]); fs[F.tid] = lb + (1.f - lb) * sigmoidf_(bf2f(pr[512 + F.tid])); }
    const v2u iv = *(const GAS v2u*)(pr + 1024 + 4 * v4);
    const f32x4 vt = (f32x4){bflo(iv.x), bfhi(iv.x), bflo(iv.y), bfhi(iv.y)};
    __syncthreads();
    f32x4 po = (f32x4){0.f, 0.f, 0.f, 0.f};
#pragma unroll
    for (int kk = 0; kk < 8; ++kk) { const float f = fs[8 * kq + kk], q = qs[8 * kq + kk]; const f32x4 s = s0[kk] * f + vt * (1.f - f); *(f32x4*)(s1p + (size_t)kk * 128) = s; po += s * q; }
    *(LAS f32x4*)&red[kq * 128 + 4 * v4] = po;
    __syncthreads();
    float o = 0.f;
    if (F.tid < 128) {
#pragma unroll
        for (int q = 0; q < 16; ++q) o += red[q * 128 + F.tid];
        const float sw = wave_sum(o * o); if (F.lane == 0) ssum[F.wave] = sw; }
    __syncthreads();
    if (h == 0) {
        const int c = F.tid; const bf16* prs = PROJ + (size_t)row * IN_E; const float* wsc = F.in[I_SCW]; const float* stp = F.in[I_SSC] + (size_t)bs * 1024;
        const float bg = bf2f(prs[2048 + c]), u0 = bf2f(prs[2560 + c]) * bf2f(prs[3072 + c]), u2 = stp[c], u1 = stp[512 + c];
        F.out[O_SCS + (size_t)bs * 1024 + c] = u1; F.out[O_SCS + (size_t)bs * 1024 + 512 + c] = u0;
        A2[(size_t)row * D + 512 + c] = (bf16)f2bf(bg * (wsc[c] * u2 + wsc[512 + c] * u1 + wsc[1024 + c] * u0));
    }
    if (F.tid < 128) { const float rstd = frsq_((ssum[0] + ssum[1]) * (1.f / 128.f) + EPS); const float g = bf2f(pr[1536 + F.tid]);
        A2[(size_t)row * D + h * 128 + F.tid] = (bf16)f2bf(o * rstd * F.in[I_HGN][F.tid] * siluf_(g)); }
    __syncthreads();
}

__device__ __forceinline__ void mix0_sc(const Ctx& F, int unit) {
    const bf16* PROJ = (const bf16*)(F.ws + WS_BIG); bf16* A2 = (bf16*)(F.ws + WS_A2);
    const int o = F.tid & 63, rg = F.tid >> 6, c0 = 8 * o;
    const float* wp = F.in[I_SCW];
    float w0[8], w1[8], w2[8];
#pragma unroll
    for (int e = 0; e < 8; ++e) { w0[e] = wp[c0 + e]; w1[e] = wp[512 + c0 + e]; w2[e] = wp[1024 + c0 + e]; }
    float u1[8], u2[8];
    const int rowb = unit * 64 + 8 * rg;
    const bool prompt = unit < 256;
    if (prompt) {
        const int t = rowb & (SEQ - 1);
        float a[8], b[8];
        if (t >= 1) { unpack8(*(const GAS v4u*)(PROJ + (size_t)(rowb - 1) * IN_E + 2560 + c0), a); unpack8(*(const GAS v4u*)(PROJ + (size_t)(rowb - 1) * IN_E + 3072 + c0), b);
#pragma unroll
            for (int e = 0; e < 8; ++e) u1[e] = a[e] * b[e]; }
        else {
#pragma unroll
            for (int e = 0; e < 8; ++e) u1[e] = 0.f; }
        if (t >= 2) { unpack8(*(const GAS v4u*)(PROJ + (size_t)(rowb - 2) * IN_E + 2560 + c0), a); unpack8(*(const GAS v4u*)(PROJ + (size_t)(rowb - 2) * IN_E + 3072 + c0), b);
#pragma unroll
            for (int e = 0; e < 8; ++e) u2[e] = a[e] * b[e]; }
        else {
#pragma unroll
            for (int e = 0; e < 8; ++e) u2[e] = 0.f; }
    }
#pragma unroll 2
    for (int r = 0; r < 8; ++r) {
        const int row = rowb + r;
        const bf16* pr = PROJ + (size_t)row * IN_E;
        float bg[8], cg[8], hv[8], u0[8];
        unpack8(*(const GAS v4u*)(pr + 2048 + c0), bg); unpack8(*(const GAS v4u*)(pr + 2560 + c0), cg); unpack8(*(const GAS v4u*)(pr + 3072 + c0), hv);
#pragma unroll
        for (int e = 0; e < 8; ++e) u0[e] = cg[e] * hv[e];
        if (!prompt) { const int bs = row - ROWS_P; const float* stp = F.in[I_SSC] + (size_t)bs * 1024 + c0;
            const f32x4 a0 = *(const f32x4*)stp, a1 = *(const f32x4*)(stp + 4), b0 = *(const f32x4*)(stp + 512), b1 = *(const f32x4*)(stp + 516);
#pragma unroll
            for (int e = 0; e < 4; ++e) { u2[e] = a0[e]; u2[4 + e] = a1[e]; u1[e] = b0[e]; u1[4 + e] = b1[e]; }
            float* so = F.out + O_SCS + (size_t)bs * 1024 + c0;
            *(f32x4*)so = b0; *(f32x4*)(so + 4) = b1; *(f32x4*)(so + 512) = (f32x4){u0[0], u0[1], u0[2], u0[3]}; *(f32x4*)(so + 516) = (f32x4){u0[4], u0[5], u0[6], u0[7]};
        } else if ((row & (SEQ - 1)) == SEQ - 1) { float* so = F.out + O_SCP + (size_t)(row >> 11) * 1024 + c0;
            *(f32x4*)so = (f32x4){u1[0], u1[1], u1[2], u1[3]}; *(f32x4*)(so + 4) = (f32x4){u1[4], u1[5], u1[6], u1[7]};
            *(f32x4*)(so + 512) = (f32x4){u0[0], u0[1], u0[2], u0[3]}; *(f32x4*)(so + 516) = (f32x4){u0[4], u0[5], u0[6], u0[7]}; }
        float y[8];
#pragma unroll
        for (int e = 0; e < 8; ++e) y[e] = bg[e] * (w0[e] * u2[e] + w1[e] * u1[e] + w2[e] * u0[e]);
        *(GAS v4u*)(A2 + (size_t)row * D + 512 + c0) = (v4u){pk2(y[0], y[1]), pk2(y[2], y[3]), pk2(y[4], y[5]), pk2(y[6], y[7])};
#pragma unroll
        for (int e = 0; e < 8; ++e) { u2[e] = u1[e]; u1[e] = u0[e]; }
    }
}
__device__ __forceinline__ void mix0_phaseA(const Ctx& F) {
    constexpr int NG = 256, NU1 = 512, NU2 = ROWS_P / 64;
    const bool mem_first = (MEMFIRST == 2) ? ((F.bid & 1) != 0) : (MEMFIRST == 1);
    for (int pass = 0; pass < 2; ++pass) {
        if ((pass == 0) == mem_first) {
            for (int rep = 0; rep < ((REP2 & 2) ? 2 : 1); ++rep)
            for (int u = F.bid; u < NU1 + NU2; u += F.G) {
                if (u < NU2) mix0_sc(F, u);
                else mix0_gla_sample(F, (u - NU2) >> 2, (u - NU2) & 3);
            }
        } else {
            for (int rep = 0; rep < ((REP2 & 1) ? 2 : 1); ++rep)
            for (int u = F.bid; u < NG; u += F.G) mix0_gla_seg(F, u);
        }
    }
}
__device__ __forceinline__ void mix0_phaseB(const Ctx& F) { for (int rep = 0; rep < ((REP2 & 16) ? 2 : 1); ++rep) for (int u = F.bid; u < 256; u += F.G) mix0_gla_fix(F, u); }

__device__ __forceinline__ void conv1_phase(const Ctx& F) {
    const bf16* PROJ = (const bf16*)(F.ws + WS_BIG); bf16* XBC = (bf16*)(F.ws + WS_XBC);
    float* DTB = (float*)(F.ws + WS_DTB); float* CSB = (float*)(F.ws + WS_CSB);
    if (F.tid >= 416) return;
    if (F.tid >= 384) {
        const int hd = F.tid - 384; const float A = -fexp_(F.in[I_ALOG][hd]), dtb = F.in[I_DTB][hd];
        for (int unit = F.vcu; unit < ROWS_T / 64; unit += F.G) {
            const int row0 = unit * 64; float run = 0.f;
            for (int r8 = 0; r8 < 64; r8 += 8) {
                unsigned short raw[8];
#pragma unroll
                for (int e = 0; e < 8; ++e) raw[e] = PROJ[(size_t)(row0 + r8 + e) * IN_O_PAD + 5120 + hd];
#pragma unroll
                for (int e = 0; e < 8; ++e) { const float dt = softplusf_(bf2f(raw[e]) + dtb); run += dt * A; DTB[(size_t)(row0 + r8 + e) * 32 + hd] = dt; CSB[(size_t)(row0 + r8 + e) * 32 + hd] = run; }
            }
        }
        return;
    }
    const int c0 = 8 * F.tid;
    const float* wp = F.in[I_MCW];
    float w0[8], w1[8], w2[8], w3[8], bs8[8];
#pragma unroll
    for (int e = 0; e < 8; ++e) { w0[e] = wp[c0 + e]; w1[e] = wp[CONVD + c0 + e]; w2[e] = wp[2 * CONVD + c0 + e]; w3[e] = wp[3 * CONVD + c0 + e]; bs8[e] = F.in[I_MCB][c0 + e]; }
    for (int unit = F.vcu; unit < ROWS_P / 16; unit += F.G) {
        const int row0 = unit * 16; const bool head = (row0 & (SEQ - 1)) == 0;
        v4u raw[19];
#pragma unroll
        for (int e = 0; e < 19; ++e) raw[e] = (e < 3 && head) ? (v4u){0u, 0u, 0u, 0u} : *(const GAS v4u*)(PROJ + (size_t)(row0 - 3 + e) * IN_O_PAD + 2048 + c0);
        float u1[8], u2[8], u3[8];
        unpack8(raw[0], u3); unpack8(raw[1], u2); unpack8(raw[2], u1);
#pragma unroll
        for (int rr = 0; rr < 16; ++rr) {
            const int row = row0 + rr; float u0[8];
            unpack8(raw[3 + rr], u0);
            if (rr == 15 && (row & (SEQ - 1)) == SEQ - 1) {
                float* so = F.out + O_MCP + (size_t)(row >> 11) * 3 * CONVD + c0;
#pragma unroll
                for (int e = 0; e < 8; ++e) { so[e] = u2[e]; so[CONVD + e] = u1[e]; so[2 * CONVD + e] = u0[e]; } }
            float y[8];
#pragma unroll
            for (int e = 0; e < 8; ++e) y[e] = siluf_(w0[e] * u3[e] + w1[e] * u2[e] + w2[e] * u1[e] + w3[e] * u0[e] + bs8[e]);
            *(GAS v4u*)(XBC + (size_t)row * CONVD + c0) = (v4u){pk2(y[0], y[1]), pk2(y[2], y[3]), pk2(y[4], y[5]), pk2(y[6], y[7])};
#pragma unroll
            for (int e = 0; e < 8; ++e) { u3[e] = u2[e]; u2[e] = u1[e]; u1[e] = u0[e]; }
        }
    }
    for (int bsi = F.vcu; bsi < ROWS_S; bsi += F.G) {
        const int row = ROWS_P + bsi;
        if (F.tid < 32) *(GAS f32x4*)((float*)(F.ws + WS_SS) + (size_t)row * 128 + 4 * F.tid) = (f32x4){0.f, 0.f, 0.f, 0.f}; float u0[8], u1[8], u2[8], u3[8];
        unpack8(*(const GAS v4u*)(PROJ + (size_t)row * IN_O_PAD + 2048 + c0), u0);
        const float* stp = F.in[I_SMC] + (size_t)bsi * 3 * CONVD + c0;
#pragma unroll
        for (int e = 0; e < 8; ++e) { u3[e] = stp[e]; u2[e] = stp[CONVD + e]; u1[e] = stp[2 * CONVD + e]; }
        float* so = F.out + O_MCS + (size_t)bsi * 3 * CONVD + c0;
#pragma unroll
        for (int e = 0; e < 8; ++e) { so[e] = u2[e]; so[CONVD + e] = u1[e]; so[2 * CONVD + e] = u0[e]; }
        float y[8];
#pragma unroll
        for (int e = 0; e < 8; ++e) y[e] = siluf_(w0[e] * u3[e] + w1[e] * u2[e] + w2[e] * u1[e] + w3[e] * u0[e] + bs8[e]);
        *(GAS v4u*)(XBC + (size_t)row * CONVD + c0) = (v4u){pk2(y[0], y[1]), pk2(y[2], y[3]), pk2(y[4], y[5]), pk2(y[6], y[7])};
    }
}

__device__ __forceinline__ void mix1_ssd_sample(const Ctx& F, int bs, int hq, int lds_off = 0) {
    const bf16* PROJ = (const bf16*)(F.ws + WS_BIG); const bf16* XBC = (const bf16*)(F.ws + WS_XBC); bf16* Y1 = (bf16*)(F.ws + WS_Y1); float* SS = (float*)(F.ws + WS_SS);
    LAS float* yl = (LAS float*)(F.lds + lds_off);
    const int g = hq >> 1, p = F.tid >> 3, sq = F.tid & 7, row = ROWS_P + bs;
    const bf16* xb = XBC + (size_t)row * CONVD; const bf16* pr = PROJ + (size_t)row * IN_O_PAD;
    f32x4 s0[4][4];
#pragma unroll
    for (int hh = 0; hh < 4; ++hh) { const float* sp = F.in[I_SSSM] + ((size_t)(bs * 32 + 4 * hq + hh) * 64 + p) * 128 + sq * 16;
#pragma unroll
        for (int j4 = 0; j4 < 4; ++j4) s0[hh][j4] = *(const f32x4*)(sp + j4 * 4); }
    f32x4 Bv[4], Cv[4];
#pragma unroll
    for (int j4 = 0; j4 < 4; ++j4) { const v2u b4 = *(const GAS v2u*)(xb + 2048 + g * 128 + sq * 16 + j4 * 4), c4 = *(const GAS v2u*)(xb + 2560 + g * 128 + sq * 16 + j4 * 4);
        Bv[j4] = (f32x4){bflo(b4.x), bfhi(b4.x), bflo(b4.y), bfhi(b4.y)}; Cv[j4] = (f32x4){bflo(c4.x), bfhi(c4.x), bflo(c4.y), bfhi(c4.y)}; }
#pragma unroll
    for (int hh = 0; hh < 4; ++hh) {
        const int hd = 4 * hq + hh;
        const float A = -fexp_(F.in[I_ALOG][hd]), Dk = F.in[I_DSK][hd], dtb = F.in[I_DTB][hd];
        const float xv = bf2f(xb[hd * 64 + p]), dt = softplusf_(bf2f(pr[5120 + hd]) + dtb), dA = fexp_(dt * A), dtx = dt * xv;
        float* s1 = F.out + O_SSMS + ((size_t)(bs * 32 + hd) * 64 + p) * 128 + sq * 16;
        f32x4 ya = (f32x4){0.f, 0.f, 0.f, 0.f};
#pragma unroll
        for (int j4 = 0; j4 < 4; ++j4) { const f32x4 s = s0[hh][j4] * dA + Bv[j4] * dtx; *(f32x4*)(s1 + j4 * 4) = s; ya += Cv[j4] * s; }
        float y = (ya[0] + ya[1]) + (ya[2] + ya[3]);
        y += __shfl_xor(y, 1); y += __shfl_xor(y, 2); y += __shfl_xor(y, 4);
        const float yg = (y + Dk * xv) * siluf_(bf2f(pr[hd * 64 + p]));
        if (sq == 0) { Y1[(size_t)row * MI + hd * 64 + p] = (bf16)f2bf(yg); yl[hh * 64 + p] = yg * yg; }
    }
    __syncthreads();
    if (F.wave < 4) { const float ss = wave_sum(yl[F.wave * 64 + F.lane]); if (F.lane < 4) SS[(size_t)row * 128 + (4 * hq + F.wave) * 4 + F.lane] = F.lane == 0 ? ss : 0.f; }
    __syncthreads();
}

__device__ __forceinline__ unsigned ssd_tile(int idx) {
    const unsigned long long tab = (0ull) | (1ull << 6) | ((1ull | (1ull << 2)) << 12) | (2ull << 18) | ((2ull | (1ull << 2)) << 24) | ((2ull | (2ull << 2)) << 30) | (3ull << 36) | ((3ull | (1ull << 2)) << 42)
                                 | ((3ull | (2ull << 2)) << 48) | ((3ull | (3ull << 2)) << 54);
    if (idx < 10) return (unsigned)(tab >> (6 * idx)) & 63u;
    return idx == 10 ? (0u | (1u << 2) | 16u) : (2u | (3u << 2) | 16u);
}
__device__ __forceinline__ void mix1_ssd_prompt(const Ctx& F, int b, int hd, int su0 = -1, int sustep = 0) {
    const bf16* PROJ = (const bf16*)(F.ws + WS_BIG); const bf16* XBC = (const bf16*)(F.ws + WS_XBC); bf16* Y1 = (bf16*)(F.ws + WS_Y1); float* SS = (float*)(F.ws + WS_SS);
    const float* DTB = (const float*)(F.ws + WS_DTB); const float* CSB = (const float*)(F.ws + WS_CSB);
    constexpr int RSB = 272, RSX = 144, RSW = 144;
    constexpr int OFF_BR = 0, OFF_CR = 17408, OFF_X = 34816, OFF_XW = 44032, OFF_W = 53248, OFF_CS = 62464, OFF_DT = 62720, SET = 62976;
    static_assert(2 * SET <= RING_BYTES, "two image sets fit the LDS ring");
    LAS unsigned char* L0 = F.lds;
    const int tid = F.tid, lane = F.lane, w = F.wave, g = lane >> 4, r15 = lane & 15, qq = r15 >> 2, pp = lane & 3;
    const int ps = w & 3, ih = w >> 2, grp = hd >> 3;
    const float Dk = F.in[I_DSK][hd];
    f32x4 st[8];
#pragma unroll
    for (int i = 0; i < 8; ++i) st[i] = (f32x4){0.f, 0.f, 0.f, 0.f};
    const int jb = tid >> 4, ob = tid & 15, jx = tid >> 3, ox = tid & 7;
    const bf16* gB = XBC + (size_t)(b * SEQ + jb) * CONVD + 2048 + grp * 128 + 8 * ob;
    const bf16* gX = XBC + (size_t)(b * SEQ + jx) * CONVD + hd * 64 + 8 * ox;
    const float* gS = (tid < 64 ? CSB : DTB) + (size_t)(b * SEQ + (tid & 63)) * 32 + hd;
    v4u B0, B1, C0, C1, X0; float sv = 0.f;
#define SSD_LOAD() do { B0 = *(const GAS v4u*)gB; B1 = *(const GAS v4u*)(gB + (size_t)32 * CONVD); C0 = *(const GAS v4u*)(gB + 512); C1 = *(const GAS v4u*)(gB + 512 + (size_t)32 * CONVD); X0 = *(const GAS v4u*)gX; \
        if (tid < 128) sv = *gS; gB += (size_t)64 * CONVD; gX += (size_t)64 * CONVD; gS += 64 * 32; } while (0)
#define SSD_STAGE(Ls) do { *(LAS v4u*)((Ls) + OFF_BR + jb * RSB + 16 * ob) = B0; *(LAS v4u*)((Ls) + OFF_BR + (jb + 32) * RSB + 16 * ob) = B1; \
        *(LAS v4u*)((Ls) + OFF_CR + jb * RSB + 16 * ob) = C0; *(LAS v4u*)((Ls) + OFF_CR + (jb + 32) * RSB + 16 * ob) = C1; *(LAS v4u*)((Ls) + OFF_X + jx * RSX + 16 * ox) = X0; \
        if (tid < 128) *(LAS float*)((Ls) + (tid < 64 ? OFF_CS : OFF_DT) + 4 * (tid & 63)) = sv; } while (0)
#define SSD_P2(Ls) do { const LAS float* CSp = (const LAS float*)((Ls) + OFF_CS); const LAS float* DTp = (const LAS float*)((Ls) + OFF_DT); \
        { const float fac = fexp_(CSp[63] - CSp[jx]) * DTp[jx]; const v4u Xc = *(const LAS v4u*)((Ls) + OFF_X + jx * RSX + 16 * ox); \
          *(LAS v4u*)((Ls) + OFF_XW + jx * RSX + 16 * ox) = (v4u){pk2(bflo(Xc.x) * fac, bfhi(Xc.x) * fac), pk2(bflo(Xc.y) * fac, bfhi(Xc.y) * fac), pk2(bflo(Xc.z) * fac, bfhi(Xc.z) * fac), pk2(bflo(Xc.w) * fac, bfhi(Xc.w) * fac)}; } \
        _Pragma("unroll") for (int rep = 0; rep < 2; ++rep) { const int idx = w + 8 * rep; \
            if (idx < 12) { const unsigned tc = ssd_tile(idx); const int it = tc & 3, jt = (tc >> 2) & 3; const bool zero = (tc & 16u) != 0u; \
                f32x4 a4 = (f32x4){0.f, 0.f, 0.f, 0.f}; \
                if (!zero) { _Pragma("unroll") for (int ks = 0; ks < 4; ++ks) { \
                        const bf16x8 a = *(const LAS bf16x8*)((Ls) + OFF_BR + (16 * jt + r15) * RSB + (32 * ks + 8 * g) * 2), bb = *(const LAS bf16x8*)((Ls) + OFF_CR + (16 * it + r15) * RSB + (32 * ks + 8 * g) * 2); \
                        a4 = MFMA16(a, bb, a4); } } \
                const int i = 16 * it + r15; const float csi = CSp[i]; float wv[4]; \
                const f32x4 cj = *(const LAS f32x4*)&CSp[16 * jt + 4 * g], dj = *(const LAS f32x4*)&DTp[16 * jt + 4 * g]; \
                _Pragma("unroll") for (int reg = 0; reg < 4; ++reg) { const int j = 16 * jt + 4 * g + reg; wv[reg] = (!zero && j <= i) ? a4[reg] * fexp_(csi - cj[reg]) * dj[reg] : 0.f; } \
                *(LAS v2u*)((Ls) + OFF_W + i * RSW + (16 * jt + 4 * g) * 2) = (v2u){pk2(wv[0], wv[1]), pk2(wv[2], wv[3])}; } } } while (0)
    SSD_LOAD(); SSD_STAGE(L0); SSD_LOAD();
    __syncthreads();
    SSD_P2(L0); SSD_STAGE(L0 + SET); SSD_LOAD();
    __syncthreads();
    float smy = 0.f;
    v4u z8 = *(const GAS v4u*)(PROJ + (size_t)(b * SEQ + (tid >> 3)) * IN_O_PAD + hd * 64 + 8 * (tid & 7));
    for (int c = 0; c < 32; ++c) {
        const int row0 = b * SEQ + c * 64;
        LAS unsigned char* L = L0 + (c & 1) * SET; LAS unsigned char* Ln = L0 + ((c + 1) & 1) * SET;
        const LAS float* CS = (const LAS float*)(L + OFF_CS);
        const float csl = CS[63];
        f32x4 sm0, sm1; v2u smb0, smb1, smc0, smc1; size_t smoff = 0; int smrow = 0, smhd = 0;
        if (su0 >= 0) { const int job = c >> 1, su = su0 + (job >> 2) * sustep; smrow = ROWS_P + (su >> 3); smhd = 4 * (su & 7) + (job & 3);
            smoff = ((size_t)((su >> 3) * 32 + smhd) * 64 + (tid >> 3)) * 128 + (tid & 7) * 16 + 8 * (c & 1);
            const float* sp = F.in[I_SSSM] + smoff; sm0 = *(const GAS f32x4*)sp; sm1 = *(const GAS f32x4*)(sp + 4);
            const bf16* xbs = XBC + (size_t)smrow * CONVD + 2048 + (smhd >> 3) * 128 + (tid & 7) * 16 + 8 * (c & 1);
            smb0 = *(const GAS v2u*)xbs; smb1 = *(const GAS v2u*)(xbs + 4); smc0 = *(const GAS v2u*)(xbs + 512); smc1 = *(const GAS v2u*)(xbs + 516); }
        f32x4 acc_y[2];
#pragma unroll
        for (int t2 = 0; t2 < 2; ++t2) {
            const int it = 2 * ih + t2; f32x4 acc = (f32x4){0.f, 0.f, 0.f, 0.f};
#pragma unroll
            for (int ks = 0; ks < 4; ++ks) {
                const bf16x8 bfrag = acc_pair_bf16(st[2 * ks], st[2 * ks + 1]);
                const v2u a0 = *(const LAS v2u*)(L + OFF_CR + (16 * it + r15) * RSB + (32 * ks + 4 * g) * 2), a1 = *(const LAS v2u*)(L + OFF_CR + (16 * it + r15) * RSB + (32 * ks + 16 + 4 * g) * 2);
                acc = MFMA16(cat64(a0, a1), bfrag, acc); }
            const f32x4 c4 = *(const LAS f32x4*)&CS[16 * it + 4 * g];
            acc = acc * (f32x4){fexp_(c4[0]), fexp_(c4[1]), fexp_(c4[2]), fexp_(c4[3])};
#pragma unroll
            for (int ks = 0; ks < 2; ++ks) {
                if (ks <= ih) {
                    const bf16x8 a = *(const LAS bf16x8*)(L + OFF_W + (16 * it + r15) * RSW + (32 * ks + 8 * g) * 2);
                    const bf16x8 xf = tr16_pair(L + OFF_X + (32 * ks + 8 * g + qq) * RSX + (16 * ps + 4 * pp) * 2, L + OFF_X + (32 * ks + 8 * g + 4 + qq) * RSX + (16 * ps + 4 * pp) * 2);
                    acc = MFMA16(a, xf, acc); } }
            acc_y[t2] = acc;
        }
        { const float el = fexp_(csl);
          const bf16x8 xw0 = tr16_pair(L + OFF_XW + (8 * g + qq) * RSX + (16 * ps + 4 * pp) * 2, L + OFF_XW + (8 * g + 4 + qq) * RSX + (16 * ps + 4 * pp) * 2);
          const bf16x8 xw1 = tr16_pair(L + OFF_XW + (32 + 8 * g + qq) * RSX + (16 * ps + 4 * pp) * 2, L + OFF_XW + (32 + 8 * g + 4 + qq) * RSX + (16 * ps + 4 * pp) * 2);
#pragma unroll
          for (int stl = 0; stl < 8; ++stl) {
              const bf16x8 a0 = tr16_pair(L + OFF_BR + (8 * g + qq) * RSB + (16 * stl + 4 * pp) * 2, L + OFF_BR + (8 * g + 4 + qq) * RSB + (16 * stl + 4 * pp) * 2);
              const bf16x8 a1 = tr16_pair(L + OFF_BR + (32 + 8 * g + qq) * RSB + (16 * stl + 4 * pp) * 2, L + OFF_BR + (32 + 8 * g + 4 + qq) * RSB + (16 * stl + 4 * pp) * 2);
              f32x4 s = st[stl] * el; s = MFMA16(a0, xw0, s); st[stl] = MFMA16(a1, xw1, s); } }
        if (c + 1 < 32) SSD_P2(Ln);
#pragma unroll
        for (int t2 = 0; t2 < 2; ++t2)
#pragma unroll
            for (int reg = 0; reg < 4; ++reg) {
                const int i = 16 * (2 * ih + t2) + 4 * g + reg;
                const float xv = bf2f(*(const LAS bf16*)(L + OFF_X + i * RSX + (16 * ps + r15) * 2));
                *(LAS float*)(L0 + YT_OFF + i * 272 + (16 * ps + r15) * 4) = acc_y[t2][reg] + Dk * xv; }
        __syncthreads();
        if (c + 2 < 32) { SSD_STAGE(L); if (c + 3 < 32) SSD_LOAD(); }
        { const int ie = tid >> 3, oe = tid & 7;
          const f32x4 y0 = *(const LAS f32x4*)(L0 + YT_OFF + ie * 272 + 32 * oe), y1 = *(const LAS f32x4*)(L0 + YT_OFF + ie * 272 + 32 * oe + 16);
          float z[8]; unpack8(z8, z);
          float yg[8];
#pragma unroll
          for (int e = 0; e < 4; ++e) { yg[e] = y0[e] * siluf_(z[e]); yg[4 + e] = y1[e] * siluf_(z[4 + e]); }
          *(GAS v4u*)(Y1 + (size_t)(row0 + ie) * MI + hd * 64 + 8 * oe) = (v4u){pk2(yg[0], yg[1]), pk2(yg[2], yg[3]), pk2(yg[4], yg[5]), pk2(yg[6], yg[7])};
          float ss = 0.f;
#pragma unroll
          for (int e = 0; e < 8; ++e) ss += yg[e] * yg[e];
          ss += dppf<0xB1>(ss); ss += dppf<0x4E>(ss); ss += __shfl_xor(ss, 4);
          if (oe == 0) *(GAS f32x4*)(SS + (size_t)(row0 + ie) * 128 + hd * 4) = (f32x4){ss, 0.f, 0.f, 0.f};
          if (c + 1 < 32) z8 = *(const GAS v4u*)(PROJ + (size_t)(row0 + 64 + ie) * IN_O_PAD + hd * 64 + 8 * oe); }
        if (su0 >= 0) {
            const int p = tid >> 3;
            const float dts = DTB[(size_t)smrow * 32 + smhd], xvs = bf2f(XBC[(size_t)smrow * CONVD + smhd * 64 + p]);
            const float dAs = fexp_(-dts * fexp_(F.in[I_ALOG][smhd])), dtx = dts * xvs;
            const f32x4 bv0 = (f32x4){bflo(smb0.x), bfhi(smb0.x), bflo(smb0.y), bfhi(smb0.y)}, bv1 = (f32x4){bflo(smb1.x), bfhi(smb1.x), bflo(smb1.y), bfhi(smb1.y)};
            const f32x4 cv0 = (f32x4){bflo(smc0.x), bfhi(smc0.x), bflo(smc0.y), bfhi(smc0.y)}, cv1 = (f32x4){bflo(smc1.x), bfhi(smc1.x), bflo(smc1.y), bfhi(smc1.y)};
            const f32x4 n0 = sm0 * dAs + bv0 * dtx, n1 = sm1 * dAs + bv1 * dtx;
            float* so = F.out + O_SSMS + smoff; *(GAS f32x4*)so = n0; *(GAS f32x4*)(so + 4) = n1;
            const f32x4 pr = cv0 * n0 + cv1 * n1; const float yp = (pr[0] + pr[1]) + (pr[2] + pr[3]);
            smy = (c & 1) ? smy + yp : yp;
            if (c & 1) { float y = smy; y += dppf<0xB1>(y); y += dppf<0x4E>(y); y += __shfl_xor(y, 4);
                const float yg = (y + F.in[I_DSK][smhd] * xvs) * siluf_(bf2f(PROJ[(size_t)smrow * IN_O_PAD + smhd * 64 + p]));
                float ss = ((tid & 7) == 0) ? yg * yg : 0.f;
                if ((tid & 7) == 0) Y1[(size_t)smrow * MI + smhd * 64 + p] = (bf16)f2bf(yg);
                ss = wave_sum(ss); if (lane == 0) (void)__hip_atomic_fetch_add(SS + (size_t)smrow * 128 + smhd * 4, ss, __ATOMIC_RELAXED, __HIP_MEMORY_SCOPE_AGENT); }
        }
        __syncthreads();
    }
#undef SSD_LOAD
#undef SSD_STAGE
#undef SSD_P2
    if (ih == 0) {
        float* sp = F.out + O_SSMP + ((size_t)(b * 32 + hd) * 64 + 16 * ps + r15) * 128;
#pragma unroll
        for (int stl = 0; stl < 8; ++stl) *(f32x4*)(sp + 16 * stl + 4 * g) = st[stl];
    }
}

__device__ __forceinline__ void mix1_phase(const Ctx& F) {
    constexpr int NU0 = 256, NU1 = ROWS_S * 8;
    if (F.G == NU0 && !SAMPLEFIRST) { mix1_ssd_prompt(F, F.vcu >> 5, F.vcu & 31, F.vcu, NU0); return; }
    if (SAMPLEFIRST) { for (int u = F.vcu; u < NU1; u += F.G) mix1_ssd_sample(F, u >> 3, u & 7); for (int u = F.vcu; u < NU0; u += F.G) mix1_ssd_prompt(F, u >> 5, u & 31); return; }
    for (int u = F.vcu; u < NU0; u += F.G) mix1_ssd_prompt(F, u >> 5, u & 31);
    for (int u = F.vcu; u < NU1; u += F.G) mix1_ssd_sample(F, u >> 3, u & 7);
}
template <int NR> __device__ __forceinline__ void norm1_rows(const Ctx& F, int rowb) {
    bf16* Y1 = (bf16*)(F.ws + WS_Y1); const float* SS = (const float*)(F.ws + WS_SS); const float* mn = F.in[I_MNORM];
    v4u y8[NR][4]; float sv[NR];
#pragma unroll
    for (int r = 0; r < NR; ++r) { const int row = rowb + r; const GAS v4u* yp = (const GAS v4u*)(Y1 + (size_t)row * MI) + F.lane;
        if (row < ROWS_T) {
#pragma unroll
            for (int i = 0; i < 4; ++i) y8[r][i] = yp[64 * i];
            sv[r] = SS[(size_t)row * 128 + 2 * F.lane] + SS[(size_t)row * 128 + 2 * F.lane + 1]; }
        else { sv[r] = 0.f;
#pragma unroll
            for (int i = 0; i < 4; ++i) y8[r][i] = (v4u){0u, 0u, 0u, 0u}; } }
#pragma unroll
    for (int r = 0; r < NR; ++r) { const int row = rowb + r; GAS v4u* yp = (GAS v4u*)(Y1 + (size_t)row * MI) + F.lane;
        float s = sv[r];
        s += __shfl_xor(s, 1); s += __shfl_xor(s, 2); s += __shfl_xor(s, 4); s += __shfl_xor(s, 8);
        const float rs = row < ROWS_T ? frsq_(s * (1.f / 512.f) + EPS) : 0.f;
#pragma unroll
        for (int i = 0; i < 4; ++i) {
            const float rr = __shfl(rs, 16 * i); const int c = (i * 64 + F.lane) * 8;
            const f32x4 m0 = *(const f32x4*)(mn + c), m1 = *(const f32x4*)(mn + c + 4); const v4u yy = y8[r][i];
            v4u o;
            o.x = pk2(bflo(yy.x) * rr * m0[0], bfhi(yy.x) * rr * m0[1]); o.y = pk2(bflo(yy.y) * rr * m0[2], bfhi(yy.y) * rr * m0[3]);
            o.z = pk2(bflo(yy.z) * rr * m1[0], bfhi(yy.z) * rr * m1[1]); o.w = pk2(bflo(yy.w) * rr * m1[2], bfhi(yy.w) * rr * m1[3]);
            yp[64 * i] = o; }
    }
}
__device__ __forceinline__ void norm1_phase(const Ctx& F) {
    const int gw = F.vcu * NWAVES + F.wave, NGW = F.G * NWAVES;
    for (int rowb = gw * 4; rowb < ROWS_P; rowb += NGW * 4) norm1_rows<4>(F, rowb);
    for (int row = ROWS_P + gw; row < M_PAD; row += NGW) norm1_rows<1>(F, row);
}

template <int EPI>
__device__ __forceinline__ void sgemm_run(const Ctx& F, const bf16* A, int lda, const bf16* Bt, int K, int KS, int rb0, int nrb, int cb0, int ncb, int uoff,
                                          bf16* O, int ldc, const float* xin_p, const float* xin_s, float* XRp, const float* gate, const float* rsq = nullptr, const float* cbv = nullptr, int ldcb = 0, int wg0 = 0, int nwg = 0) {
    constexpr int RS = 528, OFF_A = 0, OFF_B = 64 * RS, STAGE = 96 * RS;
    LAS unsigned char* L = F.lds;
    const int tid = F.tid, lane = F.lane, w = F.wave, g = lane >> 4, r15 = lane & 15, rt = w >> 1, ct = w & 1;
    const int lr = tid >> 5, lo = tid & 31;
    const int total = nrb * ncb * KS, klen = K / KS, nch = klen / 256;
    for (int rep = 0; rep < (((REP2 & 32) && KS == 1) ? 2 : 1); ++rep) {
    const int NW = nwg > 0 ? nwg : F.G, li = F.bid - wg0;
    if (li < 0 || li >= NW) continue;
    int u = (NW - 1 - li) - (uoff % NW); if (u < 0) u += NW;
    for (; u < total; u += NW) {
        const int ks = u % KS, t = u / KS, cb = cb0 + t % ncb, rb = rb0 + t / ncb;
        const bf16* ap = A + (size_t)(64 * rb + lr) * lda + ks * klen + 8 * lo;
        const bf16* bp = Bt + (size_t)(32 * cb + lr) * K + ks * klen + 8 * lo;
        v4u a0[4], b0[2];
#pragma unroll
        for (int i = 0; i < 4; ++i) a0[i] = *(const GAS v4u*)(ap + (size_t)(16 * i) * lda);
#pragma unroll
        for (int i = 0; i < 2; ++i) b0[i] = *(const GAS v4u*)(bp + (size_t)(16 * i) * K);
        f32x4 acc = (f32x4){0.f, 0.f, 0.f, 0.f};
        for (int c = 0; c < nch; ++c) {
            LAS unsigned char* S = L + (c & 1) * STAGE;
#pragma unroll
            for (int i = 0; i < 4; ++i) *(LAS v4u*)(S + OFF_A + (lr + 16 * i) * RS + 16 * lo) = a0[i];
#pragma unroll
            for (int i = 0; i < 2; ++i) *(LAS v4u*)(S + OFF_B + (lr + 16 * i) * RS + 16 * lo) = b0[i];
            if (c + 1 < nch) { ap += 256; bp += 256;
#pragma unroll
                for (int i = 0; i < 4; ++i) a0[i] = *(const GAS v4u*)(ap + (size_t)(16 * i) * lda);
#pragma unroll
                for (int i = 0; i < 2; ++i) b0[i] = *(const GAS v4u*)(bp + (size_t)(16 * i) * K); }
            __syncthreads();
#pragma unroll
            for (int q = 0; q < 8; ++q) {
                const bf16x8 af = *(const LAS bf16x8*)(S + OFF_A + (16 * rt + r15) * RS + (32 * q + 8 * g) * 2), bf = *(const LAS bf16x8*)(S + OFF_B + (16 * ct + r15) * RS + (32 * q + 8 * g) * 2);
                acc = MFMA16(bf, af, acc); }
        }
        __syncthreads();
        const int token = 64 * rb + 16 * rt + r15, n = 32 * cb + 16 * ct + 4 * g;
        if (EPI == 3) { *(f32x4*)(XRp + (size_t)token * ldc + n) = acc; }
        else if (EPI == 4) { const float rstd = frsq_(rsq[token] * (1.f / D) + EPS); const f32x4 c4 = *(const f32x4*)(cbv + (size_t)(token >> 11) * ldcb + n); const f32x4 y = acc * rstd + c4;
            *(GAS v2u*)(O + (size_t)token * ldc + n) = (v2u){pk2(y[0], y[1]), pk2(y[2], y[3])}; }
        else if (EPI == 0 || EPI == 1) {
            if (EPI == 1) {
#pragma unroll
                for (int e = 0; e < 4; ++e) { const float r = fmaxf(acc[e], 0.f); acc[e] = r * r; } }
            *(GAS v2u*)(O + (size_t)token * ldc + n) = (v2u){pk2(acc[0], acc[1]), pk2(acc[2], acc[3])};
        } else {
            const f32x4 g4 = *(const f32x4*)(gate + (size_t)pg8::mod_row(token) * MODW + n);
            float* op = XRp + (size_t)token * D + n;
            if (KS == 1) { const float* xr = token < ROWS_P ? xin_p + (size_t)token * D : xin_s + (size_t)(token - ROWS_P) * D; *(f32x4*)op = *(const f32x4*)(xr + n) + g4 * acc; }
            else {
#pragma unroll
                for (int e = 0; e < 4; ++e) (void)__hip_atomic_fetch_add(op + e, g4[e] * acc[e], __ATOMIC_RELAXED, __HIP_MEMORY_SCOPE_AGENT); }
        }
    }
    }
}

constexpr int NPHASE = 18;
__global__ void __launch_bounds__(NTHR, 2) mega_fwd(Args args) {
    extern __shared__ __attribute__((aligned(16))) unsigned char lds_raw[];
    Ctx F;
    F.lds = (LAS unsigned char*)lds_raw;
    F.tid = threadIdx.x; F.lane = F.tid & 63; F.wave = __builtin_amdgcn_readfirstlane(F.tid >> 6);
    F.G = gridDim.x; F.bid = blockIdx.x; F.vcu = (F.G % 8 == 0) ? (F.bid % 8) * (F.G / 8) + F.bid / 8 : F.bid;
    F.in = args.in; F.out = args.out; F.ws = args.ws;
    volatile LAS unsigned* MISC = (volatile LAS unsigned*)(F.lds + MISC_OFF);
    for (int u = F.tid; u < (LDS_BYTES - LDSCTL_OFF) / 4; u += NTHR) ((LAS unsigned*)(F.lds + LDSCTL_OFF))[u] = 0u;
    __syncthreads();
    const int lo = args.ph_lo, hi = args.ph_hi;
    XcdBarrier bar; bar.bar = (unsigned*)(F.ws + WS_CTL) + CW_BAR; bar.x = 0; bar.st = nullptr;
    if (hi - lo > 1) bar = xcd_barrier_post((unsigned*)(F.ws + WS_CTL) + CW_BAR, MISC + 8);

    float* mod = (float*)(F.ws + WS_MOD);
    float* XR = (float*)(F.ws + WS_XR);
    float* modL1 = mod + (size_t)NMODROW * MODW;
#define IN(k) (lo <= (k) && (k) < hi)
#define SEAM(k) do { if ((k) + 1 < hi) { xcd_barrier(bar); if (REP2 & 64) xcd_barrier(bar); } } while (0)
#define GEMM_BF16(ACT, Aoff, Boff, Ooff, N_, LDC_, K_, RSi, CBo) do { pg8::Gemm g{(const bf16*)(F.ws + (Aoff)), (const bf16*)(F.ws + (Boff)), ROWS_P, (N_), (K_)}; pg8::StaticOrder S; S.init(ROWS_P, (N_), F.G, F.bid); \
        pg8::EpiBf16<ACT> E{(bf16*)(F.ws + (Ooff)), (LDC_), RSB + (size_t)(RSi) * M_PAD, CBB + (CBo), CB_LD}; pg8::gemm_phase<pg8::EpiBf16<ACT>, pg8::StaticOrder, PG8_ALIGN, PG8_SP2>(F.lds, g, S, E); } while (0)
#define GEMM_RES(XF32, Aoff, Boff, K_, xp_, gate_, XGoff, gnw_, smod_, RSi) do { pg8::Gemm g{(const bf16*)(F.ws + (Aoff)), (const bf16*)(F.ws + (Boff)), ROWS_P, D, (K_)}; pg8::StaticOrder S; S.init(ROWS_P, D, F.G, F.bid); \
        pg8::EpiRes<XF32> E{(const void*)(xp_), XRb, (gate_), (RSi) < 0 ? nullptr : (bf16*)(F.ws + (XGoff)), (gnw_), (smod_), RSB + (size_t)((RSi) < 0 ? 0 : (RSi)) * M_PAD}; pg8::gemm_phase<pg8::EpiRes<XF32>, pg8::StaticOrder, PG8_ALIGN, PG8_SP2>(F.lds, g, S, E); } while (0)
#define SG_BF16(ACT, Aoff, Boff, Ooff, LDC_, K_, rb0_, nrb_, nt0_, nnt_, uoff_) sgemm_run<ACT>(F, (const bf16*)(F.ws + (Aoff)), (K_), (const bf16*)(F.ws + (Boff)), (K_), 1, (rb0_), (nrb_), (nt0_), (nnt_), (uoff_), \
        (bf16*)(F.ws + (Ooff)), (LDC_), nullptr, nullptr, nullptr, nullptr)
#define SG_RES(Aoff, Boff, K_, KS_, xp_, xs_, gate_) sgemm_run<2>(F, (const bf16*)(F.ws + (Aoff)), (K_), (const bf16*)(F.ws + (Boff)), (K_), (KS_), 256, 2, 0, D / 32, 0, nullptr, 0, (xp_), (xs_), XR, (gate_))
#define SG_CB(idx, Boff, ncb_, CBo, uoff_, wg0_, nwg_) sgemm_run<3>(F, (const bf16*)(F.ws + WS_SHB) + (size_t)(idx) * 192 * 1024, 1024, (const bf16*)(F.ws + (Boff)), 1024, 1, 0, 1, 0, (ncb_), (uoff_), nullptr, CB_LD, nullptr, nullptr, CBB + (CBo), nullptr, nullptr, nullptr, 0, (wg0_), (nwg_))
    float* RSB = (float*)(F.ws + WS_RS); float* CBB = (float*)(F.ws + WS_CB);
    float* XRS = XR + (size_t)ROWS_P * D;
    bf16* XRb = (bf16*)XR;
    if (IN(0)) { p0_phase(F); if ((REP_MASK >> 0) & 1) { xcd_barrier(bar); p0_phase(F); } SEAM(0); }
    if (IN(1)) { xg_phase(F, F.in[I_XP], F.in[I_XS], F.in[I_NMIX], mod + 0 * D, mod + 1 * D);
                 SG_CB(0, WS_WIE, IN_E / 32, CB_OFF0, 0, 0, 0); SEAM(1); }
    if (IN(2)) { GEMM_BF16(0, WS_H, WS_WIE, WS_BIG, IN_E, IN_E, D, 0, CB_OFF0); SG_BF16(0, WS_H, WS_WIE, WS_BIG, IN_E, D, 256, 2, 0, IN_E / 32, 0);
                 if (F.G == 256) { SG_CB(1, WS_W1, FF / 32, CB_OFF1, 0, 128, 128); SG_CB(2, WS_WIO, IN_O / 32, CB_OFF2, 128, 128, 128); SG_CB(3, WS_W1 + 8 * MiB, FF / 32, CB_OFF3, 289, 128, 128); }
                 else { SG_CB(1, WS_W1, FF / 32, CB_OFF1, 0, 0, 0); SG_CB(2, WS_WIO, IN_O / 32, CB_OFF2, 128, 0, 0); SG_CB(3, WS_W1 + 8 * MiB, FF / 32, CB_OFF3, 289, 0, 0); } SEAM(2); }
    if (IN(3)) { mix0_phaseA(F); xcd_barrier(bar); mix0_phaseB(F); if ((REP_MASK >> 3) & 1) { xcd_barrier(bar); mix0_phaseA(F); xcd_barrier(bar); mix0_phaseB(F); } SEAM(3); }
    if (IN(4)) { GEMM_RES(true, WS_A2, WS_WOE, D, F.in[I_XP], mod + 2 * D, WS_H, F.in[I_NMLP], mod + 4 * D, 1); SG_RES(WS_A2, WS_WOE, D, 1, F.in[I_XP], F.in[I_XS], mod + 2 * D); SEAM(4); }
    if (IN(5)) { norm_sample_phase(F, WS_H, XRS, F.in[I_NMLP], mod + 3 * D, mod + 4 * D); if (REP2 & 128) { xcd_barrier(bar); norm_sample_phase(F, WS_H, XRS, F.in[I_NMLP], mod + 3 * D, mod + 4 * D); } SEAM(5); }
    if (IN(6)) { GEMM_BF16(1, WS_H, WS_W1, WS_BIG, FF, FF, D, 1, CB_OFF1); SG_BF16(1, WS_H, WS_W1, WS_BIG, FF, D, 256, 2, 0, FF / 32, 0); SEAM(6); }
    if (IN(7)) { GEMM_RES(false, WS_BIG, WS_W2, FF, XRb, mod + 5 * D, WS_H, F.in[I_NMIX] + D, modL1 + 1 * D, 2); SG_RES(WS_BIG, WS_W2, FF, 4, XR, XRS, mod + 5 * D); SEAM(7); }
    if (IN(8)) { norm_sample_phase(F, WS_H, XRS, F.in[I_NMIX] + D, modL1 + 0 * D, modL1 + 1 * D); if (REP2 & 128) { xcd_barrier(bar); norm_sample_phase(F, WS_H, XRS, F.in[I_NMIX] + D, modL1 + 0 * D, modL1 + 1 * D); } SEAM(8); }
    if (IN(9)) { GEMM_BF16(0, WS_H, WS_WIO, WS_BIG, 5120, IN_O_PAD, D, 2, CB_OFF2); SG_BF16(0, WS_H, WS_WIO, WS_BIG, IN_O_PAD, D, 256, 2, 0, IN_O / 32, 0);
                 sgemm_run<4>(F, (const bf16*)(F.ws + WS_H), D, (const bf16*)(F.ws + WS_WIO), D, 1, 0, 256, 160, 1, 2 * (IN_O / 32), (bf16*)(F.ws + WS_BIG), IN_O_PAD, nullptr, nullptr, nullptr, nullptr, RSB + (size_t)2 * M_PAD, CBB + CB_OFF2, CB_LD); SEAM(9); }
    if (IN(10)) { conv1_phase(F); if ((REP_MASK >> 10) & 1) { xcd_barrier(bar); conv1_phase(F); } SEAM(10); }
    if (IN(11)) { mix1_phase(F); if ((REP_MASK >> 11) & 1) { xcd_barrier(bar); mix1_phase(F); } SEAM(11); }
    if (IN(12)) { norm1_phase(F); SEAM(12); }
    if (IN(13)) { GEMM_RES(false, WS_Y1, WS_WOO, MI, XRb, modL1 + 2 * D, WS_H3, F.in[I_NMLP] + D, modL1 + 4 * D, 3); SG_RES(WS_Y1, WS_WOO, MI, 4, XR, XRS, modL1 + 2 * D); SEAM(13); }
    if (IN(14)) { norm_sample_phase(F, WS_H3, XRS, F.in[I_NMLP] + D, modL1 + 3 * D, modL1 + 4 * D); SEAM(14); }
    if (IN(15)) { GEMM_BF16(1, WS_H3, WS_W1 + 8 * MiB, WS_BIG, FF, FF, D, 3, CB_OFF3); SG_BF16(1, WS_H3, WS_W1 + 8 * MiB, WS_BIG, FF, D, 256, 2, 0, FF / 32, 0); SEAM(15); }
    if (IN(16)) { GEMM_RES(false, WS_BIG, WS_W2 + 8 * MiB, FF, XRb, modL1 + 5 * D, WS_H, nullptr, nullptr, -1); SG_RES(WS_BIG, WS_W2 + 8 * MiB, FF, 4, XR, XRS, modL1 + 5 * D); SEAM(16); }
    if (IN(17)) { final_phase(F); }
#undef IN
#undef SEAM
}

extern "C" void kernel_launch(void* const* d_in, const int* in_sizes, int n_in, void* d_out, int out_size, void* d_ws, size_t ws_size, hipStream_t stream) {
    static int grid = 0;
    if (grid == 0) {
        if (n_in != 28 || out_size != (int)O_END || ws_size < WS_END) { fprintf(stderr, "kernel_launch: unexpected shapes: n_in %d out %d ws %zu\n", n_in, out_size, ws_size); grid = -1; return; }
        int dev = 0, cus = 0, per_cu = 0;
        if (hipGetDevice(&dev) != hipSuccess || hipDeviceGetAttribute(&cus, hipDeviceAttributeMultiprocessorCount, dev) != hipSuccess) { grid = -1; return; }
        if (hipFuncSetAttribute((const void*)mega_fwd, hipFuncAttributeMaxDynamicSharedMemorySize, LDS_BYTES) != hipSuccess) { fprintf(stderr, "kernel_launch: hipFuncSetAttribute failed\n"); grid = -1; return; }
        if (hipOccupancyMaxActiveBlocksPerMultiprocessor(&per_cu, (const void*)mega_fwd, NTHR, LDS_BYTES) != hipSuccess || per_cu < 1)
            fprintf(stderr, "kernel_launch: occupancy query reports %d workgroups per CU\n", per_cu);
        (void)hipGetLastError();
        grid = cus;
    }
    if (grid < 0) return;
    (void)hipMemsetAsync((char*)d_ws + WS_CTL, 0, CTL_ZERO_BYTES, stream);
    Args a{};
    for (int i = 0; i < 28; ++i) a.in[i] = (const float*)d_in[i];
    a.out = (float*)d_out; a.ws = (unsigned char*)d_ws;
#if MK_ONE_LAUNCH
    a.ph_lo = 0; a.ph_hi = NPHASE;
    hipLaunchKernelGGL(mega_fwd, dim3(grid), dim3(NTHR), LDS_BYTES, stream, a);
#else
    for (int ph = 0; ph < NPHASE; ++ph) { a.ph_lo = ph; a.ph_hi = ph + 1; hipLaunchKernelGGL(mega_fwd, dim3(grid), dim3(NTHR), LDS_BYTES, stream, a); }
#endif
}
```

```cpp
#include <hip/hip_runtime.h>
#include <cstdio>
#include <cstdint>
namespace pg8 {
#define PG8_LAS __attribute__((address_space(3)))
typedef unsigned short bf16_t;
typedef short bf16x8 __attribute__((ext_vector_type(8)));
typedef float f32x4 __attribute__((ext_vector_type(4)));
typedef unsigned u32x4 __attribute__((ext_vector_type(4)));
constexpr int BM = 256, BK = 64, HALF = 128, HTB = HALF * BK * 2  , STAGE_BYTES = 8 * HTB, NXCD = 8, WGM = 8;

__host__ __device__ __forceinline__ int lds_byte(int r, int c) { const int st = (r >> 4) * 2 + (c >> 5), rr = r & 15, cc = c & 31, ob = rr * 64 + cc * 2; return st * 1024 + (ob ^ (((ob >> 9) & 1) << 5)); }
__host__ __device__ __forceinline__ void stage_rc(int b, int& R, int& C) { const int st = b / 1024, sb = b % 1024, swz = sb ^ (((sb >> 9) & 1) << 5); R = (st >> 1) * 16 + swz / 64; C = (st & 1) * 32 + (swz % 64) / 2; }
__host__ __device__ __forceinline__ int perm32(int rho) { const int n = rho >> 4, i = rho & 15; return 8 * (i >> 2) + 4 * n + (i & 3); }

struct Unit { int pm, pn; };
struct Gemm { const bf16_t* A; const bf16_t* Bt; int M, N, K; };

struct StaticOrder {
    int nM, nN, nwg, G, c;
    __host__ __device__ void init(int M, int N, int G_, int c_) { nM = M / BM; nN = N / BM; nwg = nM * nN; G = G_; c = c_; }
    __host__ __device__ bool next(int i, Unit& u) const {
        const long L = (long)i * G + c; if (L >= nwg) return false;
        int wgid = (int)L; { const int q = nwg / NXCD, r = nwg % NXCD, xcd = wgid % NXCD, off = wgid / NXCD; wgid = (xcd < r ? xcd * (q + 1) : r * (q + 1) + (xcd - r) * q) + off; }
        const int nig = WGM * nN, gid = wgid / nig, fm = gid * WGM, gsz = (nM - fm) < WGM ? (nM - fm) : WGM;
        u.pm = fm + ((wgid % nig) % gsz); u.pn = (wgid % nig) / gsz; return true;
    }
    __device__ __forceinline__ void a_ready(const Unit&) const {}
    __device__ __forceinline__ void done(const Unit&) const {}
};

__device__ __forceinline__ unsigned cvt_pk_bf16(float lo, float hi) { unsigned r; asm volatile("v_cvt_pk_bf16_f32 %0, %1, %2" : "=v"(r) : "v"(lo), "v"(hi)); return r; }

constexpr int ROWS_P = 16384, ROWS_T = 16512;
__device__ __forceinline__ int mod_row(int row) { return row < ROWS_P ? (row >> 11) : (row - ROWS_P + 8); }

template <int ACT> struct EpiBf16 {
    static constexpr bool PERM = true, AFTER_DRAIN = false;
    static constexpr int XOFF = 133120;
    bf16_t* O; int ldc; const float* rs; const float* cb; int ldcb;
    __device__ __forceinline__ void prefetch(PG8_LAS unsigned char* lds, const Unit& u, int wid, int lane) const {
        if (wid == 0) __builtin_amdgcn_global_load_lds((const unsigned*)(cb + (size_t)(u.pm >> 3) * ldcb + u.pn * BM + 4 * lane), (PG8_LAS unsigned*)(lds + XOFF), 16, 0, 0);
        else if (wid == 1) __builtin_amdgcn_global_load_lds((const unsigned*)(rs + u.pm * BM + 4 * lane), (PG8_LAS unsigned*)(lds + XOFF + 1024), 16, 0, 0);
    }
    __device__ __forceinline__ void operator()(const f32x4 (&acc)[2][2][4][2], const Unit& u, int wr, int wc, int fr, int fq, PG8_LAS unsigned char* lds) const {
        const int row0 = u.pm * BM + wr * 64 + fr; const int col0 = u.pn * BM + wc * 32 + 8 * fq;
        const PG8_LAS float* cbl = (const PG8_LAS float*)(lds + XOFF) + wc * 32 + 8 * fq; const PG8_LAS float* rsl = (const PG8_LAS float*)(lds + XOFF + 1024) + wr * 64 + fr;
        f32x4 cv[2][2];
#pragma unroll
        for (int bj = 0; bj < 2; ++bj) { cv[bj][0] = *(const PG8_LAS f32x4*)(cbl + bj * HALF); cv[bj][1] = *(const PG8_LAS f32x4*)(cbl + bj * HALF + 4); }
#pragma unroll
        for (int ai = 0; ai < 2; ++ai)
#pragma unroll
            for (int m = 0; m < 4; ++m) { const int row = row0 + ai * HALF + m * 16; bf16_t* rowp = O + (size_t)row * ldc + col0;
                const float rstd = __builtin_amdgcn_rsqf(rsl[ai * HALF + m * 16] * (1.0f / 1024.0f) + 1e-6f);
#pragma unroll
                for (int bj = 0; bj < 2; ++bj) { f32x4 v0 = acc[ai][bj][m][0] * rstd + cv[bj][0], v1 = acc[ai][bj][m][1] * rstd + cv[bj][1];
                    if (ACT == 1) {
#pragma unroll
                        for (int e = 0; e < 4; ++e) { const float a = fmaxf(v0[e], 0.f), b = fmaxf(v1[e], 0.f); v0[e] = a * a; v1[e] = b * b; } }
                    u32x4 w; w.x = cvt_pk_bf16(v0[0], v0[1]); w.y = cvt_pk_bf16(v0[2], v0[3]); w.z = cvt_pk_bf16(v1[0], v1[1]); w.w = cvt_pk_bf16(v1[2], v1[3]);
                    *(u32x4*)(rowp + bj * HALF) = w; } }
    }
};

template <bool XIN_F32> struct EpiRes {
    static constexpr bool PERM = true, AFTER_DRAIN = false;
    const void* xin; bf16_t* out; const float* gate;
    bf16_t* xg; const float* gnw; const float* smod; float* rs_out;
    __device__ __forceinline__ void prefetch(PG8_LAS unsigned char*, const Unit&, int, int) const {}
    __device__ __forceinline__ void operator()(const f32x4 (&acc)[2][2][4][2], const Unit& u, int wr, int wc, int fr, int fq, PG8_LAS unsigned char*) const {
        const int col0 = u.pn * BM + wc * 32 + 8 * fq; const int b = u.pm >> 3;
        const float* gr = gate + (size_t)b * 6144;
        f32x4 g4[2][2], gm[2][2];
#pragma unroll
        for (int bj = 0; bj < 2; ++bj)
#pragma unroll
            for (int n = 0; n < 2; ++n) { const int c = col0 + bj * HALF + n * 4; g4[bj][n] = *(const f32x4*)(gr + c);
                if (xg) gm[bj][n] = *(const f32x4*)(gnw + c) * (*(const f32x4*)(smod + (size_t)b * 6144 + c) + 1.0f); }
#pragma unroll
        for (int ai = 0; ai < 2; ++ai)
#pragma unroll
        for (int mh = 0; mh < (XIN_F32 ? 4 : 1); ++mh) {
            constexpr int NM = XIN_F32 ? 1 : 4;
            u32x4 xb[4][2]; f32x4 xf[1][2][2];
#pragma unroll
            for (int mm = 0; mm < NM; ++mm)
#pragma unroll
                for (int bj = 0; bj < 2; ++bj) { const int m = mh * NM + mm; const int row = u.pm * BM + ai * HALF + wr * 64 + m * 16 + fr;
                    if (XIN_F32) { const float* xp = (const float*)xin + (size_t)row * 1024 + col0 + bj * HALF; xf[mm][bj][0] = *(const f32x4*)xp; xf[mm][bj][1] = *(const f32x4*)(xp + 4); }
                    else xb[mm][bj] = *(const u32x4*)((const bf16_t*)xin + (size_t)row * 1024 + col0 + bj * HALF); }
#pragma unroll
            for (int mm = 0; mm < NM; ++mm) { const int m = mh * NM + mm; const int row = u.pm * BM + ai * HALF + wr * 64 + m * 16 + fr; float ss = 0.f;
#pragma unroll
                for (int bj = 0; bj < 2; ++bj) { const int c = col0 + bj * HALF; f32x4 x0, x1;
                    if (XIN_F32) { x0 = xf[mm][bj][0]; x1 = xf[mm][bj][1]; }
                    else { const u32x4 xv = xb[mm][bj];
                        x0 = (f32x4){__builtin_bit_cast(float, xv.x << 16), __builtin_bit_cast(float, xv.x & 0xffff0000u), __builtin_bit_cast(float, xv.y << 16), __builtin_bit_cast(float, xv.y & 0xffff0000u)};
                        x1 = (f32x4){__builtin_bit_cast(float, xv.z << 16), __builtin_bit_cast(float, xv.z & 0xffff0000u), __builtin_bit_cast(float, xv.w << 16), __builtin_bit_cast(float, xv.w & 0xffff0000u)}; }
                    const f32x4 o0 = x0 + g4[bj][0] * acc[ai][bj][m][0], o1 = x1 + g4[bj][1] * acc[ai][bj][m][1];
                    u32x4 ow; ow.x = cvt_pk_bf16(o0[0], o0[1]); ow.y = cvt_pk_bf16(o0[2], o0[3]); ow.z = cvt_pk_bf16(o1[0], o1[1]); ow.w = cvt_pk_bf16(o1[2], o1[3]);
                    *(u32x4*)(out + (size_t)row * 1024 + c) = ow;
                    if (xg) { ss += ((o0[0] * o0[0] + o0[1] * o0[1]) + (o0[2] * o0[2] + o0[3] * o0[3])) + ((o1[0] * o1[0] + o1[1] * o1[1]) + (o1[2] * o1[2] + o1[3] * o1[3]));
                        const f32x4 y0 = o0 * gm[bj][0], y1 = o1 * gm[bj][1];
                        u32x4 w; w.x = cvt_pk_bf16(y0[0], y0[1]); w.y = cvt_pk_bf16(y0[2], y0[3]); w.z = cvt_pk_bf16(y1[0], y1[1]); w.w = cvt_pk_bf16(y1[2], y1[3]);
                        *(u32x4*)(xg + (size_t)row * 1024 + c) = w; } }
                if (xg) { ss += __shfl_xor(ss, 16); ss += __shfl_xor(ss, 32); if (fq == 0) (void)__hip_atomic_fetch_add(rs_out + row, ss, __ATOMIC_RELAXED, __HIP_MEMORY_SCOPE_AGENT); } }
        }
    }
};

template <class Epi, class Sched, bool ALIGN_EPI = false, bool SP2 = false>
__device__ __forceinline__ void gemm_phase(PG8_LAS unsigned char* lds, const Gemm g, const Sched& S, const Epi& E) {
    const int tid = threadIdx.x, wid = __builtin_amdgcn_readfirstlane(tid >> 6), lane = tid & 63, wr = wid >> 2, wc = wid & 3, fr = lane & 15, fq = lane >> 4;
    const int K = g.K, nt = K / BK;
    unsigned voffA[2], voffB[2];
#pragma unroll
    for (int i = 0; i < 2; ++i) { int R, C; stage_rc(tid * 16 + i * 8192, R, C); const int Rb = Epi::PERM ? ((R & ~31) + perm32(R & 31)) : R;
        voffA[i] = (unsigned)(R * K + C) * 2u; voffB[i] = (unsigned)(Rb * K + C) * 2u; }
    const size_t kstep = (size_t)(BK * 2);
    const size_t hstep = (size_t)HALF * K * 2;
    const size_t tstep = 2 * hstep;
    const unsigned ldsw = (unsigned)wid * 1024u;
    const int aoff = lds_byte(wr * 64 + fr, fq * 8), boff = lds_byte(wc * 32 + fr, fq * 8);
#define PG8_SA(b, h) (((b) * 2 + (h)) * HTB)
#define PG8_SB(b, h) ((4 + (b) * 2 + (h)) * HTB)
#define PG8_STAGE(bufoff, gbase, voff) do { _Pragma("unroll") for (int _i = 0; _i < 2; ++_i) \
        __builtin_amdgcn_global_load_lds((const unsigned*)((const char*)(gbase) + (voff)[_i]), (PG8_LAS unsigned*)(lds + (bufoff) + ldsw + _i * 8192), 16, 0, 0); } while (0)
#define PG8_LDA(dst, b, h) do { _Pragma("unroll") for (int m = 0; m < 4; ++m) _Pragma("unroll") for (int k = 0; k < 2; ++k) dst[m][k] = *(const PG8_LAS bf16x8*)(lds + PG8_SA(b, h) + aoff + m * 2048 + k * 1024); } while (0)
#define PG8_LDB(dst, b, h) do { _Pragma("unroll") for (int n = 0; n < 2; ++n) _Pragma("unroll") for (int k = 0; k < 2; ++k) dst[n][k] = *(const PG8_LAS bf16x8*)(lds + PG8_SB(b, h) + boff + n * 2048 + k * 1024); } while (0)
#define PG8_MMA(ai, bj, At, Bt) do { __builtin_amdgcn_s_setprio(1); _Pragma("unroll") for (int m = 0; m < 4; ++m) _Pragma("unroll") for (int n = 0; n < 2; ++n) _Pragma("unroll") for (int k = 0; k < 2; ++k) \
        acc[ai][bj][m][n] = __builtin_amdgcn_mfma_f32_16x16x32_bf16(Bt[n][k], At[m][k], acc[ai][bj][m][n], 0, 0, 0); __builtin_amdgcn_s_setprio(0); } while (0)
#define PG8_WAIT_V(n) asm volatile("s_waitcnt vmcnt(" #n ")" ::: "memory")
#define PG8_WAIT_L(n) asm volatile("s_waitcnt lgkmcnt(" #n ")" ::: "memory")
#define PG8_BAR __builtin_amdgcn_s_barrier()
#define PG8_SCHED __builtin_amdgcn_sched_barrier(0)
    Unit cur, nxt; int ui = 0;
    if (!S.next(0, cur)) return;
    f32x4 acc[2][2][4][2];
#pragma unroll
    for (int a = 0; a < 2; ++a)
#pragma unroll
        for (int b = 0; b < 2; ++b)
#pragma unroll
            for (int m = 0; m < 4; ++m)
#pragma unroll
                for (int n = 0; n < 2; ++n) acc[a][b][m][n] = (f32x4){0.f, 0.f, 0.f, 0.f};
    bf16x8 At[4][2], B0[2][2], B1[2][2];
    const char* cA = (const char*)g.A + (size_t)cur.pm * tstep; const char* cB = (const char*)g.Bt + (size_t)cur.pn * tstep;
    S.a_ready(cur);
    if constexpr (SP2) {
        PG8_STAGE(PG8_SB(0, 0), cB, voffB); PG8_STAGE(PG8_SB(0, 1), cB + hstep, voffB); PG8_STAGE(PG8_SA(0, 0), cA, voffA); PG8_STAGE(PG8_SA(0, 1), cA + hstep, voffA);
        if (wr == 1) PG8_BAR;
        PG8_WAIT_V(2); PG8_BAR;
        PG8_STAGE(PG8_SB(1, 0), cB + kstep, voffB); PG8_STAGE(PG8_SA(1, 0), cA + kstep, voffA); PG8_STAGE(PG8_SB(1, 1), cB + hstep + kstep, voffB);
        PG8_WAIT_V(6); PG8_BAR;
    } else {
        PG8_STAGE(PG8_SB(0, 0), cB, voffB); PG8_STAGE(PG8_SA(0, 0), cA, voffA); PG8_STAGE(PG8_SB(0, 1), cB + hstep, voffB); PG8_STAGE(PG8_SA(0, 1), cA + hstep, voffA);
        if (wr == 1) PG8_BAR;
        PG8_WAIT_V(4); PG8_BAR;
        PG8_STAGE(PG8_SB(1, 0), cB + kstep, voffB); PG8_STAGE(PG8_SA(1, 0), cA + kstep, voffA); PG8_STAGE(PG8_SB(1, 1), cB + hstep + kstep, voffB);
        PG8_WAIT_V(6); PG8_BAR;
    }
    for (;;) {
        const bool has_next = S.next(ui + 1, nxt);
        const char* nA = has_next ? (const char*)g.A + (size_t)nxt.pm * tstep : cA; const char* nB = has_next ? (const char*)g.Bt + (size_t)nxt.pn * tstep : cB;
        for (int t = 0; t < nt; t += 2) {
            const bool last = (t == nt - 2);
            const char* a1 = cA + (size_t)(t + 1) * kstep;
            const char* a2 = last ? nA : cA + (size_t)(t + 2) * kstep; const char* b2 = last ? nB : cB + (size_t)(t + 2) * kstep;
            const char* a3 = a2 + kstep; const char* b3 = b2 + kstep;
            if (last && has_next) S.a_ready(nxt);
            if (last) E.prefetch(lds, cur, wid, lane);
            if constexpr (SP2) {
            PG8_LDB(B0, 0, 0); PG8_LDB(B1, 0, 1); PG8_SCHED; PG8_LDA(At, 0, 0); PG8_STAGE(PG8_SA(1, 1), a1 + hstep, voffA);
            PG8_WAIT_V(8); PG8_WAIT_L(0); PG8_BAR; PG8_MMA(0, 0, At, B0); PG8_MMA(0, 1, At, B1); PG8_BAR; PG8_SCHED;
            PG8_LDA(At, 0, 1); PG8_STAGE(PG8_SB(0, 0), b2, voffB); PG8_STAGE(PG8_SB(0, 1), b2 + hstep, voffB); PG8_STAGE(PG8_SA(0, 0), a2, voffA);
            PG8_WAIT_V(8); PG8_WAIT_L(0); PG8_BAR; PG8_MMA(1, 0, At, B0); PG8_MMA(1, 1, At, B1); PG8_BAR; PG8_SCHED;
            PG8_LDB(B0, 1, 0); PG8_LDB(B1, 1, 1); PG8_SCHED; PG8_LDA(At, 1, 0); PG8_STAGE(PG8_SA(0, 1), a2 + hstep, voffA);
            PG8_WAIT_V(8); PG8_WAIT_L(0); PG8_BAR; PG8_MMA(0, 0, At, B0); PG8_MMA(0, 1, At, B1); PG8_BAR; PG8_SCHED;
            PG8_LDA(At, 1, 1); PG8_STAGE(PG8_SB(1, 0), b3, voffB); PG8_STAGE(PG8_SB(1, 1), b3 + hstep, voffB); PG8_STAGE(PG8_SA(1, 0), a3, voffA);
            PG8_WAIT_V(8); PG8_WAIT_L(0); PG8_BAR; PG8_MMA(1, 0, At, B0); PG8_MMA(1, 1, At, B1); PG8_BAR; PG8_SCHED;
            } else {
            PG8_LDB(B0, 0, 0); PG8_SCHED; PG8_LDA(At, 0, 0); PG8_STAGE(PG8_SA(1, 1), a1 + hstep, voffA);
            PG8_WAIT_L(8); PG8_BAR; PG8_WAIT_L(0); PG8_MMA(0, 0, At, B0); PG8_BAR; PG8_SCHED;
            PG8_LDB(B1, 0, 1); PG8_STAGE(PG8_SB(0, 0), b2, voffB);
            PG8_BAR; PG8_WAIT_L(0); PG8_MMA(0, 1, At, B1); PG8_BAR;
            PG8_LDA(At, 0, 1); PG8_STAGE(PG8_SA(0, 0), a2, voffA);
            PG8_BAR; PG8_WAIT_L(0); PG8_MMA(1, 0, At, B0); PG8_BAR; PG8_SCHED;
            PG8_STAGE(PG8_SB(0, 1), b2 + hstep, voffB);
            PG8_WAIT_V(6); PG8_BAR; PG8_MMA(1, 1, At, B1); PG8_BAR;
            PG8_LDB(B0, 1, 0); PG8_SCHED; PG8_LDA(At, 1, 0); PG8_STAGE(PG8_SA(0, 1), a2 + hstep, voffA);
            PG8_WAIT_L(8); PG8_BAR; PG8_WAIT_L(0); PG8_MMA(0, 0, At, B0); PG8_BAR; PG8_SCHED;
            PG8_LDB(B1, 1, 1); PG8_STAGE(PG8_SB(1, 0), b3, voffB);
            PG8_BAR; PG8_WAIT_L(0); PG8_MMA(0, 1, At, B1); PG8_BAR;
            PG8_LDA(At, 1, 1); PG8_STAGE(PG8_SA(1, 0), a3, voffA);
            PG8_BAR; PG8_WAIT_L(0); PG8_MMA(1, 0, At, B0); PG8_BAR; PG8_SCHED;
            PG8_STAGE(PG8_SB(1, 1), b3 + hstep, voffB);
            PG8_WAIT_V(6); PG8_BAR; PG8_MMA(1, 1, At, B1); PG8_BAR;
            }
        }
        if constexpr (ALIGN_EPI) { if (wr == 0) PG8_BAR; }
        if constexpr (!Epi::AFTER_DRAIN) { E(acc, cur, wr, wc, fr, fq, lds); S.done(cur); }
        if (!has_next) break;
#pragma unroll
        for (int a = 0; a < 2; ++a)
#pragma unroll
            for (int b = 0; b < 2; ++b)
#pragma unroll
                for (int m = 0; m < 4; ++m)
#pragma unroll
                    for (int n = 0; n < 2; ++n) acc[a][b][m][n] = (f32x4){0.f, 0.f, 0.f, 0.f};
        cur = nxt; cA = nA; cB = nB; ++ui;
        if constexpr (ALIGN_EPI) { if (wr == 1) PG8_BAR; }
    }
    PG8_WAIT_V(0);
    if constexpr (!ALIGN_EPI) { if (wr == 0) PG8_BAR; }
    PG8_BAR;
    if constexpr (Epi::AFTER_DRAIN) { E.fused(acc, cur, wr, wc, fr, fq, lds, wid, lane); S.done(cur); }
#undef PG8_SA
#undef PG8_SB
#undef PG8_STAGE
#undef PG8_LDA
#undef PG8_LDB
#undef PG8_MMA
#undef PG8_WAIT_V
#undef PG8_WAIT_L
#undef PG8_BAR
#undef PG8_SCHED
}
}

#ifndef PG8_SP2
#define PG8_SP2 true
#endif
#ifndef PG8_ALIGN
#define PG8_ALIGN true
#endif
#ifndef REP_MASK
#define REP_MASK 0
#endif
#ifndef REP2
#define REP2 0
#endif
#ifndef MEMFIRST
#define MEMFIRST 1
#endif
#ifndef SAMPLEFIRST
#define SAMPLEFIRST 1
#endif
#ifndef MK_ONE_LAUNCH
#define MK_ONE_LAUNCH 1
#endif

constexpr int NWAVES = 8, NTHR = 512;
constexpr int D = 1024, ROWS_P = 16384, ROWS_S = 128, ROWS_T = 16512, M_PAD = 16640, SEQ = 2048, NB = 8;
constexpr int IN_E = 3584, IN_O = 5152, IN_O_PAD = 5376, FF = 4096, MI = 2048, CONVD = 3072;
constexpr int NMODROW = 136, MODW = 6144;
constexpr float EPS = 1e-6f;
static_assert(ROWS_P == pg8::ROWS_P && ROWS_T == pg8::ROWS_T, "row constants");

constexpr size_t MiB = 1u << 20;
constexpr size_t WS_CTL = 0, CTL_ZERO_BYTES = 64 * 1024;
constexpr size_t WS_MOD = 1 * MiB;
constexpr size_t WS_WIE = 8 * MiB, WS_WOE = 15 * MiB, WS_WIO = 17 * MiB, WS_WOO = 28 * MiB, WS_W1 = 32 * MiB, WS_W2 = 48 * MiB;
constexpr size_t WS_XR = 64 * MiB;
constexpr size_t WS_H = 129 * MiB;
constexpr size_t WS_A2 = 162 * MiB;
constexpr size_t WS_Y1 = 129 * MiB;
constexpr size_t WS_BIG = 195 * MiB;
constexpr size_t WS_XBC = 366 * MiB;
constexpr size_t WS_SS = 464 * MiB;
constexpr size_t WS_DTB = 473 * MiB, WS_CSB = 476 * MiB;
constexpr size_t WS_RS = 480 * MiB;
constexpr size_t WS_SHB = 481 * MiB;
constexpr size_t WS_CB = 483 * MiB;
constexpr int CB_LD = 17152, CB_OFF0 = 0, CB_OFF1 = 3584, CB_OFF2 = 7680, CB_OFF3 = 13056;
constexpr size_t WS_H3 = WS_XBC;
constexpr size_t WS_END = 488 * MiB;
constexpr size_t WS_QB = WS_H, WS_OL = WS_H + 16 * MiB, WS_SSEG = WS_XBC, WS_DSEG = WS_XBC + 16 * MiB;
static_assert(WS_H + (size_t)M_PAD * D * 2 <= WS_A2 && WS_A2 + (size_t)M_PAD * D * 2 <= WS_BIG && WS_Y1 + (size_t)M_PAD * MI * 2 <= WS_BIG, "ws map 1");
static_assert(WS_BIG + (size_t)M_PAD * IN_O_PAD * 2 <= WS_XBC && WS_XBC + (size_t)M_PAD * CONVD * 2 <= WS_SS && WS_SS + (size_t)M_PAD * 128 * 4 <= WS_DTB && WS_DTB + (size_t)M_PAD * 32 * 4 <= WS_CSB && WS_CSB + (size_t)M_PAD * 32 * 4 <= WS_RS && WS_RS + (size_t)4 * M_PAD * 4 <= WS_SHB && WS_SHB + (size_t)4 * 192 * 1024 * 2 <= WS_CB && WS_CB + (size_t)64 * CB_LD * 4 <= WS_END, "ws map 2");
static_assert(WS_XR + (size_t)M_PAD * D * 4 <= WS_H && WS_WIO + (size_t)IN_O_PAD * D * 2 <= WS_WOO, "ws map 3");
constexpr int CW_BAR = 4096;

constexpr size_t O_Y = 0, O_HGP = 16908288, O_HGS = 17432576, O_SCP = 25821184, O_SCS = 25829376, O_SSMP = 25960448, O_SSMS = 28057600, O_MCP = 61612032, O_MCS = 61685760, O_END = 62865408;

constexpr int RING_BYTES = 131072, LDSCTL_OFF = RING_BYTES, MISC_OFF = LDSCTL_OFF + 320, YT_OFF = 133120, LDS_BYTES = 155648;

#define GAS __attribute__((address_space(1)))
#define LAS __attribute__((address_space(3)))
typedef unsigned short bf16;
typedef unsigned v4u __attribute__((ext_vector_type(4)));
typedef unsigned v2u __attribute__((ext_vector_type(2)));
typedef float f32x4 __attribute__((ext_vector_type(4)));
typedef float f32x16 __attribute__((ext_vector_type(16)));
typedef short bf16x8 __attribute__((ext_vector_type(8)));
typedef GAS unsigned gu32;
#define RLX_AGENT __ATOMIC_RELAXED, __HIP_MEMORY_SCOPE_AGENT
#define LDS_WAIT() asm volatile("s_waitcnt lgkmcnt(0)" ::: "memory")
#define VM_WAIT() asm volatile("s_waitcnt vmcnt(0)" ::: "memory")
typedef __bf16 bfv2 __attribute__((ext_vector_type(2)));
typedef float f32x2 __attribute__((ext_vector_type(2)));
__device__ __forceinline__ unsigned pk2(float lo, float hi) { const f32x2 v = {lo, hi}; return __builtin_bit_cast(unsigned, __builtin_convertvector(v, bfv2)); }
__device__ __forceinline__ unsigned f2bf(float f) { return pk2(f, 0.f) & 0xffffu; }
__device__ __forceinline__ float bf2f(unsigned h) { return __builtin_bit_cast(float, h << 16); }
__device__ __forceinline__ float bflo(unsigned w) { return __builtin_bit_cast(float, w << 16); }
__device__ __forceinline__ float bfhi(unsigned w) { return __builtin_bit_cast(float, w & 0xffff0000u); }
__device__ __forceinline__ float fexp_(float x) { return __builtin_amdgcn_exp2f(1.4426950408889634f * x); }
__device__ __forceinline__ float flog_(float x) { return 0.6931471805599453f * __builtin_amdgcn_logf(x); }
__device__ __forceinline__ float sigmoidf_(float x) { return __builtin_amdgcn_rcpf(1.f + __builtin_amdgcn_exp2f(-1.4426950408889634f * x)); }
__device__ __forceinline__ float siluf_(float x) { return x * sigmoidf_(x); }
__device__ __forceinline__ float softplusf_(float x) { return x > 15.f ? x : flog_(1.f + fexp_(x)); }
__device__ __forceinline__ float frsq_(float x) { return __builtin_amdgcn_rsqf(x); }
__device__ __forceinline__ float wave_sum(float v) {
#pragma unroll
    for (int o = 1; o < 64; o <<= 1) v += __shfl_xor(v, o);
    return v;
}

#define XB_TMO      128
#define XB_XCNT(j)  (256  + 64 * (j))
#define XB_XSUB(j)  (1280 + 64 * (j))
#define XB_XGEN(j)  (2304 + 64 * (j))
#define XB_TOP      3328
#define XB_TOPGEN   3392
#define XCD_BAR_WORDS 3456
#define XB_SPIN_CAP (1u << 18)

__device__ __forceinline__ unsigned xb_ld(unsigned* p)              { return __hip_atomic_load(p, __ATOMIC_RELAXED, __HIP_MEMORY_SCOPE_AGENT); }
__device__ __forceinline__ unsigned xb_add(unsigned* p, unsigned v) { return __hip_atomic_fetch_add(p, v, __ATOMIC_RELAXED, __HIP_MEMORY_SCOPE_AGENT); }
__device__ __forceinline__ unsigned xb_xcc_id() { return (unsigned)__builtin_amdgcn_s_getreg((3 << 11) | 20) & 0xFu; }
#define XB_SPIN(cond, bar) do { unsigned _sp = 0; while (cond) { __builtin_amdgcn_s_sleep(1); \
    if ((++_sp & 255u) == 0u) { if (xb_ld(&(bar)[XB_TMO])) break; if (_sp > XB_SPIN_CAP) { atomicAdd(&(bar)[XB_TMO], 1u); break; } } } } while (0)

struct XcdBarrier {
    unsigned* bar; unsigned x;
    volatile LAS unsigned* st;
};

__device__ __forceinline__ XcdBarrier xcd_barrier_post(unsigned* bar, volatile LAS unsigned* st) {
    XcdBarrier b; b.bar = bar; b.x = xb_xcc_id(); b.st = st;
    if (threadIdx.x == 0) (void)xb_add(&bar[XB_XCNT(b.x)], 1u);
    return b;
}
__device__ __forceinline__ void xcd_barrier_complete(unsigned* bar, unsigned x, unsigned& nloc, unsigned& nx) {
    const unsigned G = gridDim.x * gridDim.y * gridDim.z;
    unsigned sum, cnt, mine, sp = 0u;
    for (;;) {
        sum = 0u; cnt = 0u; mine = 0u;
#pragma unroll
        for (unsigned j = 0; j < 16; ++j) { const unsigned c = xb_ld(&bar[XB_XCNT(j)]); sum += c; cnt += (c > 0u) ? 1u : 0u; mine = (j == x) ? c : mine; }
        if (sum == G) break;
        __builtin_amdgcn_s_sleep(1);
        if ((++sp & 255u) == 0u) { if (xb_ld(&bar[XB_TMO])) break; if (sp > XB_SPIN_CAP) { atomicAdd(&bar[XB_TMO], 1u); break; } }
    }
    nloc = mine > 0u ? mine : 1u; nx = cnt > 0u ? cnt : 1u;
}

__device__ __forceinline__ void xcd_barrier(const XcdBarrier& b) {
    asm volatile("s_waitcnt vmcnt(0)" ::: "memory");
    __syncthreads();
    if (threadIdx.x == 0) {
        unsigned* bar = b.bar;
        __builtin_amdgcn_s_waitcnt(0);
        unsigned nloc = b.st[0], nx = b.st[1];
        if (nloc == 0u) { xcd_barrier_complete(bar, b.x, nloc, nx); b.st[0] = nloc; b.st[1] = nx; }
        const unsigned old = xb_add(&bar[XB_XSUB(b.x)], 1u);
        const unsigned gen = old / nloc;
        if (old + 1u == (gen + 1u) * nloc) {
            __builtin_amdgcn_fence(__ATOMIC_RELEASE, "agent");
            asm volatile("s_waitcnt vmcnt(0)" ::: "memory");
            const unsigned og = xb_add(&bar[XB_TOP], 1u);
            const unsigned tg = og / nx;
            if (og + 1u == (tg + 1u) * nx) xb_add(&bar[XB_TOPGEN], 1u);
            else XB_SPIN(xb_ld(&bar[XB_TOPGEN]) == tg, bar);
            xb_add(&bar[XB_XGEN(b.x)], 1u);
            __builtin_amdgcn_fence(__ATOMIC_ACQUIRE, "agent");
            asm volatile("s_waitcnt vmcnt(0)" ::: "memory");
        } else {
            XB_SPIN(xb_ld(&bar[XB_XGEN(b.x)]) == gen, bar);
            __builtin_amdgcn_fence(__ATOMIC_ACQUIRE, "agent");
            asm volatile("s_waitcnt vmcnt(0)" ::: "memory");
        }
    }
    __syncthreads();
}

struct Args { const float* in[28]; float* out; unsigned char* ws; int ph_lo, ph_hi; };
struct Ctx {
    LAS unsigned char* lds; int tid, lane, wave, G, vcu, bid;
    const float* const* in; float* out; unsigned char* ws;
};
enum { I_XP = 0, I_XS, I_CP, I_CS, I_SHG, I_SSC, I_SSSM, I_SMC, I_ADAW, I_ADAB, I_NMIX, I_NMLP, I_NFIN, I_WIE, I_HLB, I_HGN, I_SCW, I_WOE, I_WIO, I_MCW, I_MCB, I_DTB, I_ALOG, I_DSK, I_MNORM, I_WOO, I_W1, I_W2 };

__device__ __forceinline__ void p0_transpose_item(const float* W, int K, int N, bf16* WT, LAS float* scr, int item, int lane, const float* kscale = nullptr) {
    const int nblk = N / 32, kb = item / nblk, nb = item % nblk, k0 = 64 * kb, n0 = 32 * nb;
    f32x4 v[8];
#pragma unroll
    for (int i = 0; i < 8; ++i) v[i] = *(const GAS f32x4*)(W + (size_t)(k0 + 8 * i + (lane >> 3)) * N + n0 + 4 * (lane & 7));
#pragma unroll
    for (int i = 0; i < 8; ++i) { LAS float* d = scr + (8 * i + (lane >> 3)) * 33 + 4 * (lane & 7); const float ks = kscale ? kscale[k0 + 8 * i + (lane >> 3)] : 1.f; d[0] = v[i].x * ks; d[1] = v[i].y * ks; d[2] = v[i].z * ks; d[3] = v[i].w * ks; }
    LDS_WAIT(); asm volatile("" ::: "memory");
    const int c = lane & 7;
#pragma unroll
    for (int j = 0; j < 4; ++j) { const int n = (lane >> 3) + 8 * j; const LAS float* s = scr + (8 * c) * 33 + n;
        v4u o; o.x = pk2(s[0 * 33], s[1 * 33]); o.y = pk2(s[2 * 33], s[3 * 33]); o.z = pk2(s[4 * 33], s[5 * 33]); o.w = pk2(s[6 * 33], s[7 * 33]);
        *(GAS v4u*)(WT + (size_t)(n0 + n) * K + k0 + 8 * c) = o; }
    LDS_WAIT(); asm volatile("" ::: "memory");
}
__device__ __forceinline__ bf16x8 pack8(const float (&v)[8]) { v4u o; o.x = pk2(v[0], v[1]); o.y = pk2(v[2], v[3]); o.z = pk2(v[4], v[5]); o.w = pk2(v[6], v[7]); return __builtin_bit_cast(bf16x8, o); }

__device__ __forceinline__ void p0_phase(const Ctx& F) {
    float* mod = (float*)(F.ws + WS_MOD);
    for (int task = F.bid; task < 192; task += F.G) {
        const int l = task / 96, n0 = (task % 96) * 64;
        const float* W = F.in[I_ADAW] + (size_t)l * 1024 * 6144;
        f32x16 acc[5][2];
#pragma unroll
        for (int rt = 0; rt < 5; ++rt)
#pragma unroll
            for (int t = 0; t < 2; ++t)
#pragma unroll
                for (int e = 0; e < 16; ++e) acc[rt][t][e] = 0.f;
        const int r = F.lane & 31, h = F.lane >> 5;
        float wn[2][8];
        const unsigned wofs = (unsigned)((F.wave * 128 + 8 * h) * 6144 + n0 + r);
#pragma unroll
        for (int t = 0; t < 2; ++t)
#pragma unroll
            for (int j = 0; j < 8; ++j) wn[t][j] = W[wofs + (unsigned)(j * 6144 + 32 * t)];
#pragma unroll 1
        for (int ks = 0; ks < 8; ++ks) {
            const int kb = F.wave * 128 + ks * 16 + 8 * h;
            const bf16x8 bfrag0 = pack8(wn[0]), bfrag1 = pack8(wn[1]);
            if (ks + 1 < 8) {
#pragma unroll
                for (int t = 0; t < 2; ++t)
#pragma unroll
                    for (int j = 0; j < 8; ++j) wn[t][j] = W[wofs + (unsigned)((ks + 1) * 16 * 6144 + j * 6144 + 32 * t)]; }
#pragma unroll
            for (int rt = 0; rt < 5; ++rt) {
                const int row = rt * 32 + r; float cv[8];
                if (row < NMODROW) {
                    f32x4 a, b;
                    if (rt == 0) { const float* cp = row < 8 ? F.in[I_CP] + (size_t)row * 1024 : F.in[I_CS] + (size_t)(row - 8) * 1024; a = *(const f32x4*)(cp + kb); b = *(const f32x4*)(cp + kb + 4); }
                    else { const unsigned idx = (unsigned)((row - 8) * 1024 + kb); const float* cs = F.in[I_CS]; a = *(const f32x4*)(cs + idx); b = *(const f32x4*)(cs + idx + 4); }
#pragma unroll
                    for (int e = 0; e < 4; ++e) { cv[e] = siluf_(a[e]); cv[4 + e] = siluf_(b[e]); }
                } else {
#pragma unroll
                    for (int e = 0; e < 8; ++e) cv[e] = 0.f;
                }
                const bf16x8 af = pack8(cv);
                acc[rt][0] = __builtin_amdgcn_mfma_f32_32x32x16_bf16(af, bfrag0, acc[rt][0], 0, 0, 0);
                acc[rt][1] = __builtin_amdgcn_mfma_f32_32x32x16_bf16(af, bfrag1, acc[rt][1], 0, 0, 0);
                if (rt == 1 || rt == 3) __builtin_amdgcn_sched_barrier(0);
            }
        }
        LAS float* red = (LAS float*)F.lds;
#pragma unroll
        for (int rt = 0; rt < 5; ++rt)
#pragma unroll
        for (int t = 0; t < 2; ++t) {
#pragma unroll
            for (int e = 0; e < 16; ++e) red[(F.wave * 16 + e) * 64 + F.lane] = acc[rt][t][e];
            __syncthreads();
            for (int s = F.tid; s < 1024; s += NTHR) {
                float sum = 0.f;
#pragma unroll
                for (int w = 0; w < 8; ++w) sum += red[w * 1024 + s];
                const int reg = s >> 6, ln = s & 63; const int row = rt * 32 + (reg & 3) + 8 * (reg >> 2) + 4 * (ln >> 5); const int n = n0 + 32 * t + (ln & 31);
                if (row < NMODROW) { const float val = sum + F.in[I_ADAB][l * MODW + n]; mod[((size_t)l * NMODROW + row) * MODW + n] = val;
                    const int chunk = n >> 10; if (chunk == 0 || chunk == 3) ((bf16*)(F.ws + WS_SHB))[((size_t)(l * 2 + (chunk == 3)) * 192 + row) * 1024 + (n & 1023)] = (bf16)f2bf(val); }
            }
            __syncthreads();
        }
    }
    __syncthreads();
    LAS float* scr = (LAS float*)(F.lds + F.wave * 16384);
    const int gw = F.vcu * NWAVES + F.wave, NGW = F.G * NWAVES;
    constexpr int I0 = 16 * 112, I1 = 16 * 32, I2 = 16 * 161, I3 = 32 * 32, I4 = 16 * 128, I5 = 64 * 32;
    constexpr int NITEMS = I0 + I1 + I2 + I3 + 2 * I4 + 2 * I5;
    const bool split = (F.G == 256); constexpr int NPASS1 = 6 * 2048;
    for (int pass = 0; pass < 2; ++pass) {
    int it0, istep, iend;
    if (!split) { if (pass) break; it0 = gw; istep = NGW; iend = NITEMS; }
    else if (pass == 0) { it0 = gw; istep = NGW; iend = NPASS1; }
    else { if (F.bid < 192) break; it0 = NPASS1 + (F.bid - 192) * NWAVES + F.wave; istep = 64 * NWAVES; iend = NITEMS; }
    for (int it = it0; it < iend; it += istep) {
        int r = it;
        if (r < I0) { p0_transpose_item(F.in[I_WIE], 1024, IN_E, (bf16*)(F.ws + WS_WIE), scr, r, F.lane); continue; } r -= I0;
        if (r < I1) { p0_transpose_item(F.in[I_WOE], 1024, 1024, (bf16*)(F.ws + WS_WOE), scr, r, F.lane); continue; } r -= I1;
        if (r < I2) { p0_transpose_item(F.in[I_WIO], 1024, IN_O, (bf16*)(F.ws + WS_WIO), scr, r, F.lane); continue; } r -= I2;
        if (r < I3) { p0_transpose_item(F.in[I_WOO], 2048, 1024, (bf16*)(F.ws + WS_WOO), scr, r, F.lane, F.in[I_MNORM]); continue; } r -= I3;
        if (r < 2 * I4) { const int l = r / I4; p0_transpose_item(F.in[I_W1] + (size_t)l * 1024 * FF, 1024, FF, (bf16*)(F.ws + WS_W1 + l * 8 * MiB), scr, r % I4, F.lane); continue; } r -= 2 * I4;
        { const int l = r / I5; p0_transpose_item(F.in[I_W2] + (size_t)l * FF * 1024, FF, 1024, (bf16*)(F.ws + WS_W2 + l * 8 * MiB), scr, r % I5, F.lane); }
    }
    }
    { GAS v4u* z = (GAS v4u*)(F.ws + WS_RS); const int n16 = 4 * M_PAD * 4 / 16;
      for (int i = F.bid * NTHR + F.tid; i < n16; i += F.G * NTHR) z[i] = (v4u){0u, 0u, 0u, 0u}; }
    { GAS v4u* z = (GAS v4u*)(F.ws + WS_WIO + (size_t)IN_O * 1024 * 2); const int n16 = (IN_O_PAD - IN_O) * 1024 * 2 / 16;
      for (int i = F.bid * NTHR + F.tid; i < n16; i += F.G * NTHR) z[i] = (v4u){0u, 0u, 0u, 0u}; }
}

template <int NR> __device__ __forceinline__ void norm_rows(const Ctx& F, size_t hoff, int rowb, const float* xp, const float* xs, const f32x4 (&g4)[4], const float* mod_sh, const float* mod_s) {
    bf16* H = (bf16*)(F.ws + hoff);
    f32x4 v[NR][4];
#pragma unroll
    for (int r = 0; r < NR; ++r) { const int row = rowb + r;
        if (row < ROWS_T) { const float* xr = row < ROWS_P ? xp + (size_t)row * D : xs + (size_t)(row - ROWS_P) * D; const GAS f32x4* x4 = (const GAS f32x4*)xr + F.lane;
#pragma unroll
            for (int j = 0; j < 4; ++j) v[r][j] = x4[64 * j]; }
        else {
#pragma unroll
            for (int j = 0; j < 4; ++j) v[r][j] = (f32x4){0.f, 0.f, 0.f, 0.f}; } }
#pragma unroll
    for (int r = 0; r < NR; ++r) { const int row = rowb + r;
        GAS v2u* o = (GAS v2u*)(H + (size_t)row * D) + F.lane;
        if (row >= ROWS_T) {
#pragma unroll
            for (int j = 0; j < 4; ++j) o[64 * j] = (v2u){0u, 0u};
            continue; }
        const int mr = pg8::mod_row(row); float ss = 0.f;
#pragma unroll
        for (int j = 0; j < 4; ++j) ss += (v[r][j].x * v[r][j].x + v[r][j].y * v[r][j].y) + (v[r][j].z * v[r][j].z + v[r][j].w * v[r][j].w);
        const float rstd = frsq_(wave_sum(ss) * (1.f / D) + EPS);
#pragma unroll
        for (int j = 0; j < 4; ++j) { const int c = 4 * (F.lane + 64 * j);
            const f32x4 s4 = *(const f32x4*)(mod_s + (size_t)mr * MODW + c), h4 = *(const f32x4*)(mod_sh + (size_t)mr * MODW + c);
            const f32x4 y = v[r][j] * rstd * g4[j] * (s4 + 1.f) + h4;
            o[64 * j] = (v2u){pk2(y.x, y.y), pk2(y.z, y.w)}; }
    }
}
__device__ __forceinline__ void norm_sample_phase(const Ctx& F, size_t hoff, const float* xs, const float* g, const float* mod_sh, const float* mod_s) {
    const int gw = F.vcu * NWAVES + F.wave, NGW = F.G * NWAVES;
    f32x4 g4[4];
#pragma unroll
    for (int j = 0; j < 4; ++j) g4[j] = *(const f32x4*)(g + 4 * (F.lane + 64 * j));
    for (int row = ROWS_P + gw; row < M_PAD; row += NGW) norm_rows<1>(F, hoff, row, xs, xs, g4, mod_sh, mod_s);
}
__device__ __forceinline__ void norm_sample_publish(const Ctx& F, size_t hoff, const float* xs, const float* g, const float* mod_sh, const float* mod_s, int slot) {
    if (F.vcu * NWAVES >= ROWS_S) return;
    { const int gw = F.vcu * NWAVES + F.wave, NGW = F.G * NWAVES;
      f32x4 g4[4];
#pragma unroll
      for (int j = 0; j < 4; ++j) g4[j] = *(const f32x4*)(g + 4 * (F.lane + 64 * j));
      for (int row = ROWS_P + gw; row < ROWS_T; row += NGW) norm_rows<1>(F, hoff, row, xs, xs, g4, mod_sh, mod_s); }
    asm volatile("s_waitcnt vmcnt(0)" ::: "memory");
    __syncthreads();
    if (F.tid == 0) {
        __builtin_amdgcn_fence(__ATOMIC_RELEASE, "agent"); asm volatile("s_waitcnt vmcnt(0)" ::: "memory");
        (void)__hip_atomic_fetch_add((unsigned*)(F.ws + WS_CTL) + 12288 + 64 * slot, 1u, RLX_AGENT); }
}
__device__ __forceinline__ void norm_sample_wait(const Ctx& F, int slot) {
    const unsigned nown = (ROWS_S + NWAVES - 1) / NWAVES, nexp = (unsigned)F.G < nown ? (unsigned)F.G : nown;
    if (F.tid == 0) {
        unsigned* cnt = (unsigned*)(F.ws + WS_CTL) + 12288 + 64 * slot; unsigned sp = 0;
        while (__hip_atomic_load(cnt, RLX_AGENT) < nexp) { __builtin_amdgcn_s_sleep(2); if (++sp > (1u << 20)) break; }
        __builtin_amdgcn_fence(__ATOMIC_ACQUIRE, "agent"); asm volatile("s_waitcnt vmcnt(0)" ::: "memory"); }
    __syncthreads();
}
template <int NR> __device__ __forceinline__ void xg_rows(const Ctx& F, int rowb, const float* xp, const f32x4 (&g4)[4], const float* mod_s) {
    bf16* H = (bf16*)(F.ws + WS_H); float* RS = (float*)(F.ws + WS_RS);
    f32x4 v[NR][4];
#pragma unroll
    for (int r = 0; r < NR; ++r) { const GAS f32x4* x4 = (const GAS f32x4*)(xp + (size_t)(rowb + r) * D) + F.lane;
#pragma unroll
        for (int j = 0; j < 4; ++j) v[r][j] = x4[64 * j]; }
#pragma unroll
    for (int r = 0; r < NR; ++r) { const int row = rowb + r; GAS v2u* o = (GAS v2u*)(H + (size_t)row * D) + F.lane; float ss = 0.f;
#pragma unroll
        for (int j = 0; j < 4; ++j) ss += (v[r][j].x * v[r][j].x + v[r][j].y * v[r][j].y) + (v[r][j].z * v[r][j].z + v[r][j].w * v[r][j].w);
        ss = wave_sum(ss); if (F.lane == 0) RS[row] = ss;
        const int mr = row >> 11;
#pragma unroll
        for (int j = 0; j < 4; ++j) { const int c = 4 * (F.lane + 64 * j);
            const f32x4 s4 = *(const f32x4*)(mod_s + (size_t)mr * MODW + c);
            const f32x4 y = v[r][j] * g4[j] * (s4 + 1.f);
            o[64 * j] = (v2u){pk2(y.x, y.y), pk2(y.z, y.w)}; }
    }
}
__device__ __forceinline__ void xg_phase(const Ctx& F, const float* xp, const float* xs, const float* g, const float* mod_sh, const float* mod_s) {
    const int gw = F.vcu * NWAVES + F.wave, NGW = F.G * NWAVES;
    f32x4 g4[4];
#pragma unroll
    for (int j = 0; j < 4; ++j) g4[j] = *(const f32x4*)(g + 4 * (F.lane + 64 * j));
    for (int rowb = gw * 4; rowb < ROWS_P; rowb += NGW * 4) xg_rows<4>(F, rowb, xp, g4, mod_s);
    for (int row = ROWS_P + gw; row < M_PAD; row += NGW) norm_rows<1>(F, WS_H, row, xs, xs, g4, mod_sh, mod_s);
}
template <int NR, bool BF> __device__ __forceinline__ void final_rows(const Ctx& F, int rowb, const f32x4 (&g4)[4]) {
    const float* XR = (const float*)(F.ws + WS_XR); const bf16* XRb = (const bf16*)(F.ws + WS_XR);
    f32x4 v[NR][4];
#pragma unroll
    for (int r = 0; r < NR; ++r) {
        if (BF) { const GAS v2u* x2 = (const GAS v2u*)(XRb + (size_t)(rowb + r) * D) + F.lane;
#pragma unroll
            for (int j = 0; j < 4; ++j) { const v2u w = x2[64 * j]; v[r][j] = (f32x4){bflo(w.x), bfhi(w.x), bflo(w.y), bfhi(w.y)}; } }
        else { const GAS f32x4* x4 = (const GAS f32x4*)(XR + (size_t)(rowb + r) * D) + F.lane;
#pragma unroll
            for (int j = 0; j < 4; ++j) v[r][j] = x4[64 * j]; } }
#pragma unroll
    for (int r = 0; r < NR; ++r) { GAS f32x4* o = (GAS f32x4*)(F.out + O_Y + (size_t)(rowb + r) * D) + F.lane; float ss = 0.f;
#pragma unroll
        for (int j = 0; j < 4; ++j) ss += (v[r][j].x * v[r][j].x + v[r][j].y * v[r][j].y) + (v[r][j].z * v[r][j].z + v[r][j].w * v[r][j].w);
        const float rstd = frsq_(wave_sum(ss) * (1.f / D) + EPS);
#pragma unroll
        for (int j = 0; j < 4; ++j) o[64 * j] = v[r][j] * rstd * g4[j]; }
}
__device__ __forceinline__ void final_phase(const Ctx& F) {
    const float* g = F.in[I_NFIN];
    const int gw = F.vcu * NWAVES + F.wave, NGW = F.G * NWAVES;
    f32x4 g4[4];
#pragma unroll
    for (int j = 0; j < 4; ++j) g4[j] = *(const f32x4*)(g + 4 * (F.lane + 64 * j));
    for (int rowb = gw * 4; rowb < ROWS_P; rowb += NGW * 4) final_rows<4, true>(F, rowb, g4);
    for (int row = ROWS_P + gw; row < ROWS_T; row += NGW) final_rows<1, false>(F, row, g4);
}

__device__ __forceinline__ float hgrn_lb(const Ctx& F, int c) { const float* hl = F.in[I_HLB]; return sigmoidf_(hl[512 + c] - hl[c]); }

template <int CTRL> __device__ __forceinline__ float dppf(float x) { return __builtin_bit_cast(float, __builtin_amdgcn_update_dpp(0, __builtin_bit_cast(int, x), CTRL, 0xF, 0xF, false)); }
__device__ __forceinline__ float red16(float x) {
    x += dppf<0xB1>(x); x += dppf<0x4E>(x); x += dppf<0x124>(x); x += dppf<0x128>(x); return x;
}
__device__ __forceinline__ void unpack8(const v4u a, float (&f)[8]) {
#pragma unroll
    for (int e = 0; e < 4; ++e) { f[2 * e] = bflo(a[e]); f[2 * e + 1] = bfhi(a[e]); }
}
typedef short s16x4 __attribute__((ext_vector_type(4)));
__device__ __forceinline__ bf16x8 tr16_pair(LAS unsigned char* p0, LAS unsigned char* p1) {
    const s16x4 a = __builtin_amdgcn_ds_read_tr16_b64_v4i16((LAS s16x4*)p0), b = __builtin_amdgcn_ds_read_tr16_b64_v4i16((LAS s16x4*)p1);
    return __builtin_shufflevector(a, b, 0, 1, 2, 3, 4, 5, 6, 7);
}
__device__ __forceinline__ bf16x8 cat64(v2u a, v2u b) { return __builtin_bit_cast(bf16x8, (v4u){a.x, a.y, b.x, b.y}); }
__device__ __forceinline__ bf16x8 acc_pair_bf16(f32x4 a, f32x4 b) { return __builtin_bit_cast(bf16x8, (v4u){pk2(a[0], a[1]), pk2(a[2], a[3]), pk2(b[0], b[1]), pk2(b[2], b[3])}); }
#define MFMA16(a, b, c) __builtin_amdgcn_mfma_f32_16x16x32_bf16((a), (b), (c), 0, 0, 0)

__device__ __forceinline__ void mix0_gla_seg(const Ctx& F, int unit) {
    const int seg = unit & 7, h = (unit >> 3) & 3, b = unit >> 5;
    bf16* QB = (bf16*)(F.ws + WS_QB); bf16* OL = (bf16*)(F.ws + WS_OL); float* SSEG = (float*)(F.ws + WS_SSEG); float* DSEG = (float*)(F.ws + WS_DSEG);
    const bf16* PROJ = (const bf16*)(F.ws + WS_BIG);
    constexpr int RS1 = 272, RSA = 80;
    constexpr int OFF_QD = 0, OFF_KD = 8704, OFF_KT = 17408, OFF_V = 26112, OFF_ATT = 34816, OFF_LF = 37376, OFF_PS = 53760, OFF_DEC = 55808, OFF_SSQ = 56320, OFF_OT = 57344;
    LAS unsigned char* L = F.lds;
    LAS float* LF = (LAS float*)(L + OFF_LF); LAS float* PS = (LAS float*)(L + OFF_PS); LAS float* DEC = (LAS float*)(L + OFF_DEC); LAS float* SSQ = (LAS float*)(L + OFF_SSQ);
    const int tid = F.tid, lane = F.lane, w = F.wave, g = lane >> 4, r15 = lane & 15, qq = r15 >> 2, pp = lane & 3;
    const int j1 = tid >> 4, ko = tid & 15;
    const int k2 = tid & 127, part = tid >> 7;
    float lbv[8];
#pragma unroll
    for (int e = 0; e < 8; ++e) lbv[e] = hgrn_lb(F, h * 128 + 8 * ko + e);
    float bc[8];
#pragma unroll
    for (int e = 0; e < 8; ++e) bc[e] = 0.f;
    f32x4 st[8];
#pragma unroll
    for (int i = 0; i < 8; ++i) st[i] = (f32x4){0.f, 0.f, 0.f, 0.f};
    const bf16* prow = PROJ + (size_t)(b * SEQ + seg * 256 + j1) * IN_E + h * 128 + 8 * ko;
    v4u q8 = *(const GAS v4u*)prow, z8 = *(const GAS v4u*)(prow + 512), i8 = *(const GAS v4u*)(prow + 1024);
    for (int c = 0; c < 8; ++c) {
        const int row0 = b * SEQ + seg * 256 + c * 32;
        float qf[8], kf[8];
        { float lf[8];
#pragma unroll
          for (int e = 0; e < 4; ++e) {
              qf[2 * e] = bflo(q8[e]); qf[2 * e + 1] = bfhi(q8[e]);
              const float f0 = lbv[2 * e] + (1.f - lbv[2 * e]) * sigmoidf_(bflo(z8[e])), f1 = lbv[2 * e + 1] + (1.f - lbv[2 * e + 1]) * sigmoidf_(bfhi(z8[e]));
              kf[2 * e] = 1.f - f0; kf[2 * e + 1] = 1.f - f1; lf[2 * e] = __logf(f0); lf[2 * e + 1] = __logf(f1); }
          *(LAS f32x4*)&LF[j1 * 128 + 8 * ko] = (f32x4){lf[0], lf[1], lf[2], lf[3]}; *(LAS f32x4*)&LF[j1 * 128 + 8 * ko + 4] = (f32x4){lf[4], lf[5], lf[6], lf[7]};
          *(LAS v4u*)(L + OFF_V + j1 * RS1 + 16 * ko) = i8; }
        if (c + 1 < 8) { prow += (size_t)32 * IN_E; q8 = *(const GAS v4u*)prow; z8 = *(const GAS v4u*)(prow + 512); i8 = *(const GAS v4u*)(prow + 1024); }
        __syncthreads();
        { float x[8];
#pragma unroll
          for (int e = 0; e < 8; ++e) x[e] = LF[(8 * part + e) * 128 + k2];
#pragma unroll
          for (int e = 1; e < 8; ++e) x[e] += x[e - 1];
#pragma unroll
          for (int e = 0; e < 8; ++e) LF[(8 * part + e) * 128 + k2] = x[e];
          PS[part * 128 + k2] = x[7]; }
        __syncthreads();
        { const int pj = j1 >> 3;
          f32x4 o0 = (f32x4){0.f, 0.f, 0.f, 0.f}, o1 = o0, t0 = o0, t1 = o0;
#pragma unroll
          for (int p = 0; p < 3; ++p) { const f32x4 a = *(const LAS f32x4*)&PS[p * 128 + 8 * ko], bb = *(const LAS f32x4*)&PS[p * 128 + 8 * ko + 4];
              t0 += a; t1 += bb; if (p < pj) { o0 += a; o1 += bb; } }
          const f32x4 b0 = *(const LAS f32x4*)&LF[j1 * 128 + 8 * ko] + o0, b1 = *(const LAS f32x4*)&LF[j1 * 128 + 8 * ko + 4] + o1;
          const f32x4 l0 = *(const LAS f32x4*)&LF[31 * 128 + 8 * ko] + t0, l1 = *(const LAS f32x4*)&LF[31 * 128 + 8 * ko + 4] + t1;
          float qd[8], kd[8], kt[8];
#pragma unroll
          for (int e = 0; e < 8; ++e) { const float bv = e < 4 ? b0[e & 3] : b1[e & 3], lv = e < 4 ? l0[e & 3] : l1[e & 3];
              qd[e] = qf[e] * __expf(bv); kd[e] = kf[e] * __expf(-bv); kt[e] = kf[e] * __expf(lv - bv); }
          *(LAS v4u*)(L + OFF_QD + j1 * RS1 + 16 * ko) = (v4u){pk2(qd[0], qd[1]), pk2(qd[2], qd[3]), pk2(qd[4], qd[5]), pk2(qd[6], qd[7])};
          *(LAS v4u*)(L + OFF_KD + j1 * RS1 + 16 * ko) = (v4u){pk2(kd[0], kd[1]), pk2(kd[2], kd[3]), pk2(kd[4], kd[5]), pk2(kd[6], kd[7])};
          *(LAS v4u*)(L + OFF_KT + j1 * RS1 + 16 * ko) = (v4u){pk2(kt[0], kt[1]), pk2(kt[2], kt[3]), pk2(kt[4], kt[5]), pk2(kt[6], kt[7])};
          { float qb[8];
#pragma unroll
            for (int e = 0; e < 8; ++e) qb[e] = qd[e] * fexp_(bc[e]);
            *(GAS v4u*)(QB + (size_t)(row0 + j1) * 512 + h * 128 + 8 * ko) = (v4u){pk2(qb[0], qb[1]), pk2(qb[2], qb[3]), pk2(qb[4], qb[5]), pk2(qb[6], qb[7])};
#pragma unroll
            for (int e = 0; e < 8; ++e) bc[e] += (e < 4 ? l0[e & 3] : l1[e & 3]); }
          if (j1 == 0) { *(LAS f32x4*)&DEC[8 * ko] = (f32x4){__expf(l0[0]), __expf(l0[1]), __expf(l0[2]), __expf(l0[3])}; *(LAS f32x4*)&DEC[8 * ko + 4] = (f32x4){__expf(l1[0]), __expf(l1[1]), __expf(l1[2]), __expf(l1[3])}; } }
        __syncthreads();
        if (w < 4) {
            const int it = w >> 1, jt = w & 1; f32x4 a4 = (f32x4){0.f, 0.f, 0.f, 0.f};
            if (jt <= it) {
#pragma unroll
                for (int ks = 0; ks < 4; ++ks) {
                    const bf16x8 a = *(const LAS bf16x8*)(L + OFF_QD + (16 * it + r15) * RS1 + (32 * ks + 8 * g) * 2), bb = *(const LAS bf16x8*)(L + OFF_KD + (16 * jt + r15) * RS1 + (32 * ks + 8 * g) * 2);
                    a4 = MFMA16(a, bb, a4); } }
#pragma unroll
            for (int reg = 0; reg < 4; ++reg) { const int i = 16 * it + 4 * g + reg, j = 16 * jt + r15;
                *(LAS bf16*)(L + OFF_ATT + i * RSA + 2 * j) = (bf16)f2bf(j <= i ? a4[reg] : 0.f); }
        }
        f32x4 acc_o[2] = {(f32x4){0.f, 0.f, 0.f, 0.f}, (f32x4){0.f, 0.f, 0.f, 0.f}};
#pragma unroll
        for (int ks = 0; ks < 4; ++ks) {
            const bf16x8 bfrag = acc_pair_bf16(st[2 * ks], st[2 * ks + 1]);
#pragma unroll
            for (int it = 0; it < 2; ++it) {
                const v2u a0 = *(const LAS v2u*)(L + OFF_QD + (16 * it + r15) * RS1 + (32 * ks + 4 * g) * 2), a1 = *(const LAS v2u*)(L + OFF_QD + (16 * it + r15) * RS1 + (32 * ks + 16 + 4 * g) * 2);
                acc_o[it] = MFMA16(cat64(a0, a1), bfrag, acc_o[it]); } }
        __syncthreads();
        const bf16x8 vfrag = tr16_pair(L + OFF_V + (8 * g + qq) * RS1 + (16 * w + 4 * pp) * 2, L + OFF_V + (8 * g + 4 + qq) * RS1 + (16 * w + 4 * pp) * 2);
#pragma unroll
        for (int it = 0; it < 2; ++it) { const bf16x8 a = *(const LAS bf16x8*)(L + OFF_ATT + (16 * it + r15) * RSA + 16 * g); acc_o[it] = MFMA16(a, vfrag, acc_o[it]); }
#pragma unroll
        for (int kt8 = 0; kt8 < 8; ++kt8) {
            const bf16x8 a = tr16_pair(L + OFF_KT + (8 * g + qq) * RS1 + (16 * kt8 + 4 * pp) * 2, L + OFF_KT + (8 * g + 4 + qq) * RS1 + (16 * kt8 + 4 * pp) * 2);
            const f32x4 d4 = *(const LAS f32x4*)&DEC[16 * kt8 + 4 * g];
            st[kt8] = MFMA16(a, vfrag, st[kt8] * d4); }
#pragma unroll
        for (int it = 0; it < 2; ++it)
#pragma unroll
            for (int reg = 0; reg < 4; ++reg) *(LAS bf16*)(L + OFF_OT + (16 * it + 4 * g + reg) * RS1 + (16 * w + r15) * 2) = (bf16)f2bf(acc_o[it][reg]);
        __syncthreads();
        *(GAS v4u*)(OL + (size_t)(row0 + j1) * 512 + h * 128 + 8 * ko) = *(const LAS v4u*)(L + OFF_OT + j1 * RS1 + 16 * ko);
    }
    if (j1 == 0) { *(GAS f32x4*)(DSEG + unit * 128 + 8 * ko) = (f32x4){fexp_(bc[0]), fexp_(bc[1]), fexp_(bc[2]), fexp_(bc[3])}; *(GAS f32x4*)(DSEG + unit * 128 + 8 * ko + 4) = (f32x4){fexp_(bc[4]), fexp_(bc[5]), fexp_(bc[6]), fexp_(bc[7])}; }
#pragma unroll
    for (int kt8 = 0; kt8 < 8; ++kt8) *(GAS f32x4*)(SSEG + (size_t)unit * 16384 + ((w * 8 + kt8) * 64 + lane) * 4) = st[kt8];
    __syncthreads();
}

__device__ __forceinline__ void mix0_gla_fix(const Ctx& F, int unit) {
    const int seg = unit & 7, h = (unit >> 3) & 3, b = unit >> 5;
    const bf16* PROJ = (const bf16*)(F.ws + WS_BIG); bf16* A2 = (bf16*)(F.ws + WS_A2);
    const bf16* QB = (const bf16*)(F.ws + WS_QB); const bf16* OL = (const bf16*)(F.ws + WS_OL); const float* SSEG = (const float*)(F.ws + WS_SSEG); const float* DSEG = (const float*)(F.ws + WS_DSEG);
    constexpr int RS1 = 272, RSO = 528; constexpr int OFF_QD = 0, OFF_O32 = 8704;
    LAS unsigned char* L = F.lds;
    const int tid = F.tid, lane = F.lane, w = F.wave, g = lane >> 4, r15 = lane & 15;
    const int j1 = tid >> 4, ko = tid & 15;
    float gn8[8];
#pragma unroll
    for (int e = 0; e < 8; ++e) gn8[e] = F.in[I_HGN][8 * ko + e];
    const size_t rowj = (size_t)(b * SEQ + seg * 256 + j1);
    const bf16* qrow = QB + rowj * 512 + h * 128 + 8 * ko; const bf16* orow = OL + rowj * 512 + h * 128 + 8 * ko; const bf16* grow = PROJ + rowj * IN_E + 1536 + h * 128 + 8 * ko;
    v4u q8 = *(const GAS v4u*)qrow, o8 = *(const GAS v4u*)orow, g8 = *(const GAS v4u*)grow;
    f32x4 st[8];
#pragma unroll
    for (int i = 0; i < 8; ++i) st[i] = (f32x4){0.f, 0.f, 0.f, 0.f};
    int sp = 0;
    for (; sp + 1 < seg; sp += 2) {
        const float* ss = SSEG + (size_t)(unit - seg + sp) * 16384 + (size_t)(w * 8 * 64 + lane) * 4; const float* dd = DSEG + (unit - seg + sp) * 128;
        f32x4 sv[8], sw[8], dv[8], dw[8];
#pragma unroll
        for (int kt8 = 0; kt8 < 8; ++kt8) { sv[kt8] = *(const GAS f32x4*)(ss + kt8 * 256); sw[kt8] = *(const GAS f32x4*)(ss + 16384 + kt8 * 256); }
#pragma unroll
        for (int kt8 = 0; kt8 < 8; ++kt8) { dv[kt8] = *(const f32x4*)(dd + 16 * kt8 + 4 * g); dw[kt8] = *(const f32x4*)(dd + 128 + 16 * kt8 + 4 * g); }
#pragma unroll
        for (int kt8 = 0; kt8 < 8; ++kt8) st[kt8] = (st[kt8] * dv[kt8] + sv[kt8]) * dw[kt8] + sw[kt8];
    }
    if (sp < seg) {
        const float* ss = SSEG + (size_t)(unit - seg + sp) * 16384 + (size_t)(w * 8 * 64 + lane) * 4; const float* dd = DSEG + (unit - seg + sp) * 128;
        f32x4 sv[8];
#pragma unroll
        for (int kt8 = 0; kt8 < 8; ++kt8) sv[kt8] = *(const GAS f32x4*)(ss + kt8 * 256);
#pragma unroll
        for (int kt8 = 0; kt8 < 8; ++kt8) { const f32x4 d4 = *(const f32x4*)(dd + 16 * kt8 + 4 * g); st[kt8] = st[kt8] * d4 + sv[kt8]; }
    }
    if (seg == 7) {
        float* hgp = F.out + O_HGP + (size_t)((b * 4 + h) * 128) * 128;
        const float* ss = SSEG + (size_t)unit * 16384 + (size_t)(w * 8 * 64 + lane) * 4; const float* dd = DSEG + unit * 128;
#pragma unroll
        for (int kt8 = 0; kt8 < 8; ++kt8) { const f32x4 d4 = *(const f32x4*)(dd + 16 * kt8 + 4 * g); const f32x4 fin = st[kt8] * d4 + *(const GAS f32x4*)(ss + kt8 * 256);
#pragma unroll
            for (int reg = 0; reg < 4; ++reg) hgp[(size_t)(16 * kt8 + 4 * g + reg) * 128 + 16 * w + r15] = fin[reg]; }
    }
    bf16x8 bfr[4];
#pragma unroll
    for (int ks = 0; ks < 4; ++ks) bfr[ks] = acc_pair_bf16(st[2 * ks], st[2 * ks + 1]);
    for (int c = 0; c < 8; ++c) {
        const size_t row = rowj + (size_t)c * 32;
        *(LAS v4u*)(L + OFF_QD + j1 * RS1 + 16 * ko) = q8;
        const v4u oc = o8, gc = g8;
        if (c + 1 < 8) { qrow += (size_t)32 * 512; orow += (size_t)32 * 512; grow += (size_t)32 * IN_E; q8 = *(const GAS v4u*)qrow; o8 = *(const GAS v4u*)orow; g8 = *(const GAS v4u*)grow; }
        __syncthreads();
        f32x4 acc_o[2] = {(f32x4){0.f, 0.f, 0.f, 0.f}, (f32x4){0.f, 0.f, 0.f, 0.f}};
#pragma unroll
        for (int ks = 0; ks < 4; ++ks)
#pragma unroll
            for (int it = 0; it < 2; ++it) {
                const v2u a0 = *(const LAS v2u*)(L + OFF_QD + (16 * it + r15) * RS1 + (32 * ks + 4 * g) * 2), a1 = *(const LAS v2u*)(L + OFF_QD + (16 * it + r15) * RS1 + (32 * ks + 16 + 4 * g) * 2);
                acc_o[it] = MFMA16(cat64(a0, a1), bfr[ks], acc_o[it]); }
#pragma unroll
        for (int it = 0; it < 2; ++it)
#pragma unroll
            for (int reg = 0; reg < 4; ++reg) *(LAS float*)(L + OFF_O32 + (16 * it + 4 * g + reg) * RSO + (16 * w + r15) * 4) = acc_o[it][reg];
        __syncthreads();
        { const f32x4 c0 = *(const LAS f32x4*)(L + OFF_O32 + j1 * RSO + 32 * ko), c1 = *(const LAS f32x4*)(L + OFF_O32 + j1 * RSO + 32 * ko + 16);
          float o[8], gt[8];
          unpack8(oc, o); unpack8(gc, gt);
#pragma unroll
          for (int e = 0; e < 4; ++e) { o[e] += c0[e]; o[4 + e] += c1[e]; }
          float ss = 0.f;
#pragma unroll
          for (int e = 0; e < 8; ++e) ss += o[e] * o[e];
          const float rstd = frsq_(red16(ss) * (1.f / 128.f) + EPS);
          float y[8];
#pragma unroll
          for (int e = 0; e < 8; ++e) y[e] = o[e] * rstd * gn8[e] * siluf_(gt[e]);
          *(GAS v4u*)(A2 + row * D + h * 128 + 8 * ko) = (v4u){pk2(y[0], y[1]), pk2(y[2], y[3]), pk2(y[4], y[5]), pk2(y[6], y[7])}; }
    }
    __syncthreads();
}

__device__ __forceinline__ void mix0_gla_sample(const Ctx& F, int bs, int h) {
    const bf16* PROJ = (const bf16*)(F.ws + WS_BIG); bf16* A2 = (bf16*)(F.ws + WS_A2);
    LAS float* qs = (LAS float*)F.lds; LAS float* fs = qs + 128; LAS float* ssum = qs + 256; LAS float* red = qs + 512;
    const int v4 = F.tid & 31, kq = F.tid >> 5, row = ROWS_P + bs;
    const bf16* pr = PROJ + (size_t)row * IN_E + h * 128;
    const size_t base = (size_t)((bs * 4 + h) * 128) * 128;
    const float* s0p = F.in[I_SHG] + base + (size_t)(8 * kq) * 128 + 4 * v4; float* s1p = F.out + O_HGS + base + (size_t)(8 * kq) * 128 + 4 * v4;
    f32x4 s0[8];
#pragma unroll
    for (int kk = 0; kk < 8; ++kk) s0[kk] = *(const f32x4*)(s0p + (size_t)kk * 128);
    if (F.tid < 128) { const float lb = hgrn_lb(F, h * 128 + F.tid); qs[F.tid] = bf2f(pr[F.tid]); fs[F.tid] = lb + (1.f - lb) * sigmoidf_(bf2f(pr[512 + F.tid])); }
    const v2u iv = *(const GAS v2u*)(pr + 1024 + 4 * v4);
    const f32x4 vt = (f32x4){bflo(iv.x), bfhi(iv.x), bflo(iv.y), bfhi(iv.y)};
    __syncthreads();
    f32x4 po = (f32x4){0.f, 0.f, 0.f, 0.f};
#pragma unroll
    for (int kk = 0; kk < 8; ++kk) { const float f = fs[8 * kq + kk], q = qs[8 * kq + kk]; const f32x4 s = s0[kk] * f + vt * (1.f - f); *(f32x4*)(s1p + (size_t)kk * 128) = s; po += s * q; }
    *(LAS f32x4*)&red[kq * 128 + 4 * v4] = po;
    __syncthreads();
    float o = 0.f;
    if (F.tid < 128) {
#pragma unroll
        for (int q = 0; q < 16; ++q) o += red[q * 128 + F.tid];
        const float sw = wave_sum(o * o); if (F.lane == 0) ssum[F.wave] = sw; }
    __syncthreads();
    if (h == 0) {
        const int c = F.tid; const bf16* prs = PROJ + (size_t)row * IN_E; const float* wsc = F.in[I_SCW]; const float* stp = F.in[I_SSC] + (size_t)bs * 1024;
        const float bg = bf2f(prs[2048 + c]), u0 = bf2f(prs[2560 + c]) * bf2f(prs[3072 + c]), u2 = stp[c], u1 = stp[512 + c];
        F.out[O_SCS + (size_t)bs * 1024 + c] = u1; F.out[O_SCS + (size_t)bs * 1024 + 512 + c] = u0;
        A2[(size_t)row * D + 512 + c] = (bf16)f2bf(bg * (wsc[c] * u2 + wsc[512 + c] * u1 + wsc[1024 + c] * u0));
    }
    if (F.tid < 128) { const float rstd = frsq_((ssum[0] + ssum[1]) * (1.f / 128.f) + EPS); const float g = bf2f(pr[1536 + F.tid]);
        A2[(size_t)row * D + h * 128 + F.tid] = (bf16)f2bf(o * rstd * F.in[I_HGN][F.tid] * siluf_(g)); }
    __syncthreads();
}

__device__ __forceinline__ void mix0_sc(const Ctx& F, int unit) {
    const bf16* PROJ = (const bf16*)(F.ws + WS_BIG); bf16* A2 = (bf16*)(F.ws + WS_A2);
    const int o = F.tid & 63, rg = F.tid >> 6, c0 = 8 * o;
    const float* wp = F.in[I_SCW];
    float w0[8], w1[8], w2[8];
#pragma unroll
    for (int e = 0; e < 8; ++e) { w0[e] = wp[c0 + e]; w1[e] = wp[512 + c0 + e]; w2[e] = wp[1024 + c0 + e]; }
    float u1[8], u2[8];
    const int rowb = unit * 64 + 8 * rg;
    const bool prompt = unit < 256;
    if (prompt) {
        const int t = rowb & (SEQ - 1);
        float a[8], b[8];
        if (t >= 1) { unpack8(*(const GAS v4u*)(PROJ + (size_t)(rowb - 1) * IN_E + 2560 + c0), a); unpack8(*(const GAS v4u*)(PROJ + (size_t)(rowb - 1) * IN_E + 3072 + c0), b);
#pragma unroll
            for (int e = 0; e < 8; ++e) u1[e] = a[e] * b[e]; }
        else {
#pragma unroll
            for (int e = 0; e < 8; ++e) u1[e] = 0.f; }
        if (t >= 2) { unpack8(*(const GAS v4u*)(PROJ + (size_t)(rowb - 2) * IN_E + 2560 + c0), a); unpack8(*(const GAS v4u*)(PROJ + (size_t)(rowb - 2) * IN_E + 3072 + c0), b);
#pragma unroll
            for (int e = 0; e < 8; ++e) u2[e] = a[e] * b[e]; }
        else {
#pragma unroll
            for (int e = 0; e < 8; ++e) u2[e] = 0.f; }
    }
#pragma unroll 2
    for (int r = 0; r < 8; ++r) {
        const int row = rowb + r;
        const bf16* pr = PROJ + (size_t)row * IN_E;
        float bg[8], cg[8], hv[8], u0[8];
        unpack8(*(const GAS v4u*)(pr + 2048 + c0), bg); unpack8(*(const GAS v4u*)(pr + 2560 + c0), cg); unpack8(*(const GAS v4u*)(pr + 3072 + c0), hv);
#pragma unroll
        for (int e = 0; e < 8; ++e) u0[e] = cg[e] * hv[e];
        if (!prompt) { const int bs = row - ROWS_P; const float* stp = F.in[I_SSC] + (size_t)bs * 1024 + c0;
            const f32x4 a0 = *(const f32x4*)stp, a1 = *(const f32x4*)(stp + 4), b0 = *(const f32x4*)(stp + 512), b1 = *(const f32x4*)(stp + 516);
#pragma unroll
            for (int e = 0; e < 4; ++e) { u2[e] = a0[e]; u2[4 + e] = a1[e]; u1[e] = b0[e]; u1[4 + e] = b1[e]; }
            float* so = F.out + O_SCS + (size_t)bs * 1024 + c0;
            *(f32x4*)so = b0; *(f32x4*)(so + 4) = b1; *(f32x4*)(so + 512) = (f32x4){u0[0], u0[1], u0[2], u0[3]}; *(f32x4*)(so + 516) = (f32x4){u0[4], u0[5], u0[6], u0[7]};
        } else if ((row & (SEQ - 1)) == SEQ - 1) { float* so = F.out + O_SCP + (size_t)(row >> 11) * 1024 + c0;
            *(f32x4*)so = (f32x4){u1[0], u1[1], u1[2], u1[3]}; *(f32x4*)(so + 4) = (f32x4){u1[4], u1[5], u1[6], u1[7]};
            *(f32x4*)(so + 512) = (f32x4){u0[0], u0[1], u0[2], u0[3]}; *(f32x4*)(so + 516) = (f32x4){u0[4], u0[5], u0[6], u0[7]}; }
        float y[8];
#pragma unroll
        for (int e = 0; e < 8; ++e) y[e] = bg[e] * (w0[e] * u2[e] + w1[e] * u1[e] + w2[e] * u0[e]);
        *(GAS v4u*)(A2 + (size_t)row * D + 512 + c0) = (v4u){pk2(y[0], y[1]), pk2(y[2], y[3]), pk2(y[4], y[5]), pk2(y[6], y[7])};
#pragma unroll
        for (int e = 0; e < 8; ++e) { u2[e] = u1[e]; u1[e] = u0[e]; }
    }
}
__device__ __forceinline__ void mix0_phaseA(const Ctx& F) {
    constexpr int NG = 256, NU1 = 512, NU2 = ROWS_P / 64;
    const bool mem_first = (MEMFIRST == 2) ? ((F.bid & 1) != 0) : (MEMFIRST == 1);
    for (int pass = 0; pass < 2; ++pass) {
        if ((pass == 0) == mem_first) {
            for (int rep = 0; rep < ((REP2 & 2) ? 2 : 1); ++rep)
            for (int u = F.bid; u < NU1 + NU2; u += F.G) {
                if (u < NU2) mix0_sc(F, u);
                else mix0_gla_sample(F, (u - NU2) >> 2, (u - NU2) & 3);
            }
        } else {
            for (int rep = 0; rep < ((REP2 & 1) ? 2 : 1); ++rep)
            for (int u = F.bid; u < NG; u += F.G) mix0_gla_seg(F, u);
        }
    }
}
__device__ __forceinline__ void mix0_phaseB(const Ctx& F) { for (int rep = 0; rep < ((REP2 & 16) ? 2 : 1); ++rep) for (int u = F.bid; u < 256; u += F.G) mix0_gla_fix(F, u); }

__device__ __forceinline__ void conv1_phase(const Ctx& F) {
    const bf16* PROJ = (const bf16*)(F.ws + WS_BIG); bf16* XBC = (bf16*)(F.ws + WS_XBC);
    float* DTB = (float*)(F.ws + WS_DTB); float* CSB = (float*)(F.ws + WS_CSB);
    if (F.tid >= 416) return;
    if (F.tid >= 384) {
        const int hd = F.tid - 384; const float A = -fexp_(F.in[I_ALOG][hd]), dtb = F.in[I_DTB][hd];
        for (int unit = F.vcu; unit < ROWS_P / 64; unit += F.G) {
            const int row0 = unit * 64; float run = 0.f;
            unsigned short raw[64];
#pragma unroll
            for (int e = 0; e < 64; ++e) raw[e] = PROJ[(size_t)(row0 + e) * IN_O_PAD + 5120 + hd];
            const size_t o = (size_t)((row0 >> 11) * 32 + hd) * SEQ + (row0 & (SEQ - 1));
#pragma unroll
            for (int r8 = 0; r8 < 64; r8 += 8) {
                float dtv[8], csv[8];
#pragma unroll
                for (int e = 0; e < 8; ++e) { dtv[e] = softplusf_(bf2f(raw[r8 + e]) + dtb); run += dtv[e] * A; csv[e] = run; }
                *(GAS f32x4*)(DTB + o + r8) = (f32x4){dtv[0], dtv[1], dtv[2], dtv[3]}; *(GAS f32x4*)(DTB + o + r8 + 4) = (f32x4){dtv[4], dtv[5], dtv[6], dtv[7]};
                *(GAS f32x4*)(CSB + o + r8) = (f32x4){csv[0], csv[1], csv[2], csv[3]}; *(GAS f32x4*)(CSB + o + r8 + 4) = (f32x4){csv[4], csv[5], csv[6], csv[7]};
            }
        }
        return;
    }
    const int c0 = 8 * F.tid;
    const float* wp = F.in[I_MCW];
    float w0[8], w1[8], w2[8], w3[8], bs8[8];
#pragma unroll
    for (int e = 0; e < 8; ++e) { w0[e] = wp[c0 + e]; w1[e] = wp[CONVD + c0 + e]; w2[e] = wp[2 * CONVD + c0 + e]; w3[e] = wp[3 * CONVD + c0 + e]; bs8[e] = F.in[I_MCB][c0 + e]; }
    for (int unit = F.vcu; unit < ROWS_P / 32; unit += F.G) {
        const int row0 = unit * 32; const bool head = (row0 & (SEQ - 1)) == 0;
        v4u raw[35];
#pragma unroll
        for (int e = 0; e < 35; ++e) raw[e] = (e < 3 && head) ? (v4u){0u, 0u, 0u, 0u} : *(const GAS v4u*)(PROJ + (size_t)(row0 - 3 + e) * IN_O_PAD + 2048 + c0);
        float u1[8], u2[8], u3[8];
        unpack8(raw[0], u3); unpack8(raw[1], u2); unpack8(raw[2], u1);
#pragma unroll
        for (int rr = 0; rr < 32; ++rr) {
            const int row = row0 + rr; float u0[8];
            unpack8(raw[3 + rr], u0);
            if (rr == 31 && (row & (SEQ - 1)) == SEQ - 1) {
                float* so = F.out + O_MCP + (size_t)(row >> 11) * 3 * CONVD + c0;
#pragma unroll
                for (int e = 0; e < 8; ++e) { so[e] = u2[e]; so[CONVD + e] = u1[e]; so[2 * CONVD + e] = u0[e]; } }
            float y[8];
#pragma unroll
            for (int e = 0; e < 8; ++e) y[e] = siluf_(w0[e] * u3[e] + w1[e] * u2[e] + w2[e] * u1[e] + w3[e] * u0[e] + bs8[e]);
            *(GAS v4u*)(XBC + (size_t)row * CONVD + c0) = (v4u){pk2(y[0], y[1]), pk2(y[2], y[3]), pk2(y[4], y[5]), pk2(y[6], y[7])};
#pragma unroll
            for (int e = 0; e < 8; ++e) { u3[e] = u2[e]; u2[e] = u1[e]; u1[e] = u0[e]; }
        }
    }
    for (int bsi = F.vcu; bsi < ROWS_S; bsi += F.G) {
        const int row = ROWS_P + bsi;
        if (F.tid < 32) *(GAS f32x4*)((float*)(F.ws + WS_SS) + (size_t)row * 128 + 4 * F.tid) = (f32x4){0.f, 0.f, 0.f, 0.f}; float u0[8], u1[8], u2[8], u3[8];
        unpack8(*(const GAS v4u*)(PROJ + (size_t)row * IN_O_PAD + 2048 + c0), u0);
        const float* stp = F.in[I_SMC] + (size_t)bsi * 3 * CONVD + c0;
#pragma unroll
        for (int e = 0; e < 8; ++e) { u3[e] = stp[e]; u2[e] = stp[CONVD + e]; u1[e] = stp[2 * CONVD + e]; }
        float* so = F.out + O_MCS + (size_t)bsi * 3 * CONVD + c0;
#pragma unroll
        for (int e = 0; e < 8; ++e) { so[e] = u2[e]; so[CONVD + e] = u1[e]; so[2 * CONVD + e] = u0[e]; }
        float y[8];
#pragma unroll
        for (int e = 0; e < 8; ++e) y[e] = siluf_(w0[e] * u3[e] + w1[e] * u2[e] + w2[e] * u1[e] + w3[e] * u0[e] + bs8[e]);
        *(GAS v4u*)(XBC + (size_t)row * CONVD + c0) = (v4u){pk2(y[0], y[1]), pk2(y[2], y[3]), pk2(y[4], y[5]), pk2(y[6], y[7])};
    }
}

__device__ __forceinline__ void mix1_ssd_sample(const Ctx& F, int bs, int hq, int lds_off = 0) {
    const bf16* PROJ = (const bf16*)(F.ws + WS_BIG); const bf16* XBC = (const bf16*)(F.ws + WS_XBC); bf16* Y1 = (bf16*)(F.ws + WS_Y1); float* SS = (float*)(F.ws + WS_SS);
    LAS float* yl = (LAS float*)(F.lds + lds_off);
    const int g = hq >> 1, p = F.tid >> 3, sq = F.tid & 7, row = ROWS_P + bs;
    const bf16* xb = XBC + (size_t)row * CONVD; const bf16* pr = PROJ + (size_t)row * IN_O_PAD;
    f32x4 s0[4][4];
#pragma unroll
    for (int hh = 0; hh < 4; ++hh) { const float* sp = F.in[I_SSSM] + ((size_t)(bs * 32 + 4 * hq + hh) * 64 + p) * 128 + sq * 4;
#pragma unroll
        for (int j4 = 0; j4 < 4; ++j4) s0[hh][j4] = *(const f32x4*)(sp + j4 * 32); }
    f32x4 Bv[4], Cv[4];
#pragma unroll
    for (int j4 = 0; j4 < 4; ++j4) { const v2u b4 = *(const GAS v2u*)(xb + 2048 + g * 128 + sq * 4 + j4 * 32), c4 = *(const GAS v2u*)(xb + 2560 + g * 128 + sq * 4 + j4 * 32);
        Bv[j4] = (f32x4){bflo(b4.x), bfhi(b4.x), bflo(b4.y), bfhi(b4.y)}; Cv[j4] = (f32x4){bflo(c4.x), bfhi(c4.x), bflo(c4.y), bfhi(c4.y)}; }
    float alg4[4], dsk4[4], dtb4[4]; unsigned xr4[4], zr4[4], dr4[4];
#pragma unroll
    for (int hh = 0; hh < 4; ++hh) { const int hd = 4 * hq + hh; alg4[hh] = F.in[I_ALOG][hd]; dsk4[hh] = F.in[I_DSK][hd]; dtb4[hh] = F.in[I_DTB][hd];
        xr4[hh] = xb[hd * 64 + p]; zr4[hh] = pr[hd * 64 + p]; dr4[hh] = pr[5120 + hd]; }
#pragma unroll
    for (int hh = 0; hh < 4; ++hh) {
        const int hd = 4 * hq + hh;
        const float A = -fexp_(alg4[hh]), Dk = dsk4[hh], dtb = dtb4[hh];
        const float xv = bf2f(xr4[hh]), dt = softplusf_(bf2f(dr4[hh]) + dtb), dA = fexp_(dt * A), dtx = dt * xv;
        float* s1 = F.out + O_SSMS + ((size_t)(bs * 32 + hd) * 64 + p) * 128 + sq * 4;
        f32x4 ya = (f32x4){0.f, 0.f, 0.f, 0.f};
#pragma unroll
        for (int j4 = 0; j4 < 4; ++j4) { const f32x4 s = s0[hh][j4] * dA + Bv[j4] * dtx; *(f32x4*)(s1 + j4 * 32) = s; ya += Cv[j4] * s; }
        float y = (ya[0] + ya[1]) + (ya[2] + ya[3]);
        y += dppf<0xB1>(y); y += dppf<0x4E>(y); y += __shfl_xor(y, 4);
        const float yg = (y + Dk * xv) * siluf_(bf2f(zr4[hh]));
        if (sq == 0) { Y1[(size_t)row * MI + hd * 64 + p] = (bf16)f2bf(yg); yl[hh * 64 + p] = yg * yg; }
    }
    __syncthreads();
    if (F.wave < 4) { const float ss = wave_sum(yl[F.wave * 64 + F.lane]); if (F.lane < 4) SS[(size_t)row * 128 + (4 * hq + F.wave) * 4 + F.lane] = F.lane == 0 ? ss : 0.f; }
    __syncthreads();
}

__device__ __forceinline__ unsigned ssd_tile(int idx) {
    const unsigned long long tab = (0ull) | (1ull << 6) | ((1ull | (1ull << 2)) << 12) | (2ull << 18) | ((2ull | (1ull << 2)) << 24) | ((2ull | (2ull << 2)) << 30) | (3ull << 36) | ((3ull | (1ull << 2)) << 42)
                                 | ((3ull | (2ull << 2)) << 48) | ((3ull | (3ull << 2)) << 54);
    if (idx < 10) return (unsigned)(tab >> (6 * idx)) & 63u;
    return idx == 10 ? (0u | (1u << 2) | 16u) : (2u | (3u << 2) | 16u);
}
__device__ __forceinline__ void mix1_ssd_prompt(const Ctx& F, int b, int hd, int su0 = -1, int sustep = 0) {
    const bf16* PROJ = (const bf16*)(F.ws + WS_BIG); const bf16* XBC = (const bf16*)(F.ws + WS_XBC); bf16* Y1 = (bf16*)(F.ws + WS_Y1); float* SS = (float*)(F.ws + WS_SS);
    const float* DTB = (const float*)(F.ws + WS_DTB); const float* CSB = (const float*)(F.ws + WS_CSB);
    constexpr int RSB = 272, RSX = 144, RSW = 144;
    constexpr int OFF_BR = 0, OFF_CR = 17408, OFF_X = 34816, OFF_XW = 44032, OFF_W = 53248, OFF_CS = 62464, OFF_DT = 62720, SET = 62976;
    static_assert(2 * SET <= RING_BYTES, "two image sets fit the LDS ring");
    LAS unsigned char* L0 = F.lds;
    const int tid = F.tid, lane = F.lane, w = F.wave, g = lane >> 4, r15 = lane & 15, qq = r15 >> 2, pp = lane & 3;
    const int ps = w & 3, ih = w >> 2, grp = hd >> 3;
    const float Dk = F.in[I_DSK][hd];
    f32x4 st[8];
#pragma unroll
    for (int i = 0; i < 8; ++i) st[i] = (f32x4){0.f, 0.f, 0.f, 0.f};
    const int jb = tid >> 4, ob = tid & 15, jx = tid >> 3, ox = tid & 7;
    const bf16* gB = XBC + (size_t)(b * SEQ + jb) * CONVD + 2048 + grp * 128 + 8 * ob;
    const bf16* gX = XBC + (size_t)(b * SEQ + jx) * CONVD + hd * 64 + 8 * ox;
    const float* gS = (tid < 64 ? CSB : DTB) + (size_t)(b * 32 + hd) * SEQ + (tid & 63);
    v4u B0, B1, C0, C1, X0; float sv = 0.f;
#define SSD_LOAD() do { B0 = *(const GAS v4u*)gB; B1 = *(const GAS v4u*)(gB + (size_t)32 * CONVD); C0 = *(const GAS v4u*)(gB + 512); C1 = *(const GAS v4u*)(gB + 512 + (size_t)32 * CONVD); X0 = *(const GAS v4u*)gX; \
        if (tid < 128) sv = *gS; gB += (size_t)64 * CONVD; gX += (size_t)64 * CONVD; gS += 64; } while (0)
#define SSD_STAGE(Ls) do { *(LAS v4u*)((Ls) + OFF_BR + jb * RSB + 16 * ob) = B0; *(LAS v4u*)((Ls) + OFF_BR + (jb + 32) * RSB + 16 * ob) = B1; \
        *(LAS v4u*)((Ls) + OFF_CR + jb * RSB + 16 * ob) = C0; *(LAS v4u*)((Ls) + OFF_CR + (jb + 32) * RSB + 16 * ob) = C1; *(LAS v4u*)((Ls) + OFF_X + jx * RSX + 16 * ox) = X0; \
        if (tid < 128) *(LAS float*)((Ls) + (tid < 64 ? OFF_CS : OFF_DT) + 4 * (tid & 63)) = sv; } while (0)
#define SSD_P2(Ls) do { const LAS float* CSp = (const LAS float*)((Ls) + OFF_CS); const LAS float* DTp = (const LAS float*)((Ls) + OFF_DT); \
        { const float fac = fexp_(CSp[63] - CSp[jx]) * DTp[jx]; const v4u Xc = *(const LAS v4u*)((Ls) + OFF_X + jx * RSX + 16 * ox); \
          *(LAS v4u*)((Ls) + OFF_XW + jx * RSX + 16 * ox) = (v4u){pk2(bflo(Xc.x) * fac, bfhi(Xc.x) * fac), pk2(bflo(Xc.y) * fac, bfhi(Xc.y) * fac), pk2(bflo(Xc.z) * fac, bfhi(Xc.z) * fac), pk2(bflo(Xc.w) * fac, bfhi(Xc.w) * fac)}; } \
        _Pragma("unroll") for (int rep = 0; rep < 2; ++rep) { const int idx = w + 8 * rep; \
            if (idx < 12) { const unsigned tc = ssd_tile(idx); const int it = tc & 3, jt = (tc >> 2) & 3; const bool zero = (tc & 16u) != 0u; \
                f32x4 a4 = (f32x4){0.f, 0.f, 0.f, 0.f}; \
                if (!zero) { _Pragma("unroll") for (int ks = 0; ks < 4; ++ks) { \
                        const bf16x8 a = *(const LAS bf16x8*)((Ls) + OFF_BR + (16 * jt + r15) * RSB + (32 * ks + 8 * g) * 2), bb = *(const LAS bf16x8*)((Ls) + OFF_CR + (16 * it + r15) * RSB + (32 * ks + 8 * g) * 2); \
                        a4 = MFMA16(a, bb, a4); } } \
                const int i = 16 * it + r15; const float csi = CSp[i]; float wv[4]; \
                const f32x4 cj = *(const LAS f32x4*)&CSp[16 * jt + 4 * g], dj = *(const LAS f32x4*)&DTp[16 * jt + 4 * g]; \
                _Pragma("unroll") for (int reg = 0; reg < 4; ++reg) { const int j = 16 * jt + 4 * g + reg; wv[reg] = (!zero && j <= i) ? a4[reg] * fexp_(csi - cj[reg]) * dj[reg] : 0.f; } \
                *(LAS v2u*)((Ls) + OFF_W + i * RSW + (16 * jt + 4 * g) * 2) = (v2u){pk2(wv[0], wv[1]), pk2(wv[2], wv[3])}; } } } while (0)
    SSD_LOAD(); SSD_STAGE(L0); SSD_LOAD();
    __syncthreads();
    SSD_P2(L0); SSD_STAGE(L0 + SET); SSD_LOAD();
    __syncthreads();
    float smy = 0.f;
    v4u z8 = *(const GAS v4u*)(PROJ + (size_t)(b * SEQ + (tid >> 3)) * IN_O_PAD + hd * 64 + 8 * (tid & 7));
    for (int c = 0; c < 32; ++c) {
        const int row0 = b * SEQ + c * 64;
        LAS unsigned char* L = L0 + (c & 1) * SET; LAS unsigned char* Ln = L0 + ((c + 1) & 1) * SET;
        const LAS float* CS = (const LAS float*)(L + OFF_CS);
        const float csl = CS[63];
        f32x4 sm0, sm1; v2u smb0, smb1, smc0, smc1; size_t smoff = 0; int smrow = 0, smhd = 0;
        if (su0 >= 0) { const int job = c >> 1, su = su0 + (job >> 2) * sustep; smrow = ROWS_P + (su >> 3); smhd = 4 * (su & 7) + (job & 3);
            smoff = ((size_t)((su >> 3) * 32 + smhd) * 64 + (tid >> 3)) * 128 + (tid & 7) * 16 + 8 * (c & 1);
            const float* sp = F.in[I_SSSM] + smoff; sm0 = *(const GAS f32x4*)sp; sm1 = *(const GAS f32x4*)(sp + 4);
            const bf16* xbs = XBC + (size_t)smrow * CONVD + 2048 + (smhd >> 3) * 128 + (tid & 7) * 16 + 8 * (c & 1);
            smb0 = *(const GAS v2u*)xbs; smb1 = *(const GAS v2u*)(xbs + 4); smc0 = *(const GAS v2u*)(xbs + 512); smc1 = *(const GAS v2u*)(xbs + 516); }
        f32x4 acc_y[2];
#pragma unroll
        for (int t2 = 0; t2 < 2; ++t2) {
            const int it = 2 * ih + t2; f32x4 acc = (f32x4){0.f, 0.f, 0.f, 0.f};
#pragma unroll
            for (int ks = 0; ks < 4; ++ks) {
                const bf16x8 bfrag = acc_pair_bf16(st[2 * ks], st[2 * ks + 1]);
                const v2u a0 = *(const LAS v2u*)(L + OFF_CR + (16 * it + r15) * RSB + (32 * ks + 4 * g) * 2), a1 = *(const LAS v2u*)(L + OFF_CR + (16 * it + r15) * RSB + (32 * ks + 16 + 4 * g) * 2);
                acc = MFMA16(cat64(a0, a1), bfrag, acc); }
            const f32x4 c4 = *(const LAS f32x4*)&CS[16 * it + 4 * g];
            acc = acc * (f32x4){fexp_(c4[0]), fexp_(c4[1]), fexp_(c4[2]), fexp_(c4[3])};
#pragma unroll
            for (int ks = 0; ks < 2; ++ks) {
                if (ks <= ih) {
                    const bf16x8 a = *(const LAS bf16x8*)(L + OFF_W + (16 * it + r15) * RSW + (32 * ks + 8 * g) * 2);
                    const bf16x8 xf = tr16_pair(L + OFF_X + (32 * ks + 8 * g + qq) * RSX + (16 * ps + 4 * pp) * 2, L + OFF_X + (32 * ks + 8 * g + 4 + qq) * RSX + (16 * ps + 4 * pp) * 2);
                    acc = MFMA16(a, xf, acc); } }
            acc_y[t2] = acc;
        }
        { const float el = fexp_(csl);
          const bf16x8 xw0 = tr16_pair(L + OFF_XW + (8 * g + qq) * RSX + (16 * ps + 4 * pp) * 2, L + OFF_XW + (8 * g + 4 + qq) * RSX + (16 * ps + 4 * pp) * 2);
          const bf16x8 xw1 = tr16_pair(L + OFF_XW + (32 + 8 * g + qq) * RSX + (16 * ps + 4 * pp) * 2, L + OFF_XW + (32 + 8 * g + 4 + qq) * RSX + (16 * ps + 4 * pp) * 2);
#pragma unroll
          for (int stl = 0; stl < 8; ++stl) {
              const bf16x8 a0 = tr16_pair(L + OFF_BR + (8 * g + qq) * RSB + (16 * stl + 4 * pp) * 2, L + OFF_BR + (8 * g + 4 + qq) * RSB + (16 * stl + 4 * pp) * 2);
              const bf16x8 a1 = tr16_pair(L + OFF_BR + (32 + 8 * g + qq) * RSB + (16 * stl + 4 * pp) * 2, L + OFF_BR + (32 + 8 * g + 4 + qq) * RSB + (16 * stl + 4 * pp) * 2);
              f32x4 s = st[stl] * el; s = MFMA16(a0, xw0, s); st[stl] = MFMA16(a1, xw1, s); } }
        if (c + 1 < 32) SSD_P2(Ln);
#pragma unroll
        for (int t2 = 0; t2 < 2; ++t2)
#pragma unroll
            for (int reg = 0; reg < 4; ++reg) {
                const int i = 16 * (2 * ih + t2) + 4 * g + reg;
                const float xv = bf2f(*(const LAS bf16*)(L + OFF_X + i * RSX + (16 * ps + r15) * 2));
                *(LAS float*)(L0 + YT_OFF + i * 272 + (16 * ps + r15) * 4) = acc_y[t2][reg] + Dk * xv; }
        __syncthreads();
        if (c + 2 < 32) { SSD_STAGE(L); if (c + 3 < 32) SSD_LOAD(); }
        { const int ie = tid >> 3, oe = tid & 7;
          const f32x4 y0 = *(const LAS f32x4*)(L0 + YT_OFF + ie * 272 + 32 * oe), y1 = *(const LAS f32x4*)(L0 + YT_OFF + ie * 272 + 32 * oe + 16);
          float z[8]; unpack8(z8, z);
          float yg[8];
#pragma unroll
          for (int e = 0; e < 4; ++e) { yg[e] = y0[e] * siluf_(z[e]); yg[4 + e] = y1[e] * siluf_(z[4 + e]); }
          *(GAS v4u*)(Y1 + (size_t)(row0 + ie) * MI + hd * 64 + 8 * oe) = (v4u){pk2(yg[0], yg[1]), pk2(yg[2], yg[3]), pk2(yg[4], yg[5]), pk2(yg[6], yg[7])};
          float ss = 0.f;
#pragma unroll
          for (int e = 0; e < 8; ++e) ss += yg[e] * yg[e];
          ss += dppf<0xB1>(ss); ss += dppf<0x4E>(ss); ss += __shfl_xor(ss, 4);
          if (oe == 0) SS[(size_t)(b * 32 + hd) * SEQ + c * 64 + ie] = ss;
          if (c + 1 < 32) z8 = *(const GAS v4u*)(PROJ + (size_t)(row0 + 64 + ie) * IN_O_PAD + hd * 64 + 8 * oe); }
        if (su0 >= 0) {
            const int p = tid >> 3;
            const float dts = softplusf_(bf2f(PROJ[(size_t)smrow * IN_O_PAD + 5120 + smhd]) + F.in[I_DTB][smhd]), xvs = bf2f(XBC[(size_t)smrow * CONVD + smhd * 64 + p]);
            const float dAs = fexp_(-dts * fexp_(F.in[I_ALOG][smhd])), dtx = dts * xvs;
            const f32x4 bv0 = (f32x4){bflo(smb0.x), bfhi(smb0.x), bflo(smb0.y), bfhi(smb0.y)}, bv1 = (f32x4){bflo(smb1.x), bfhi(smb1.x), bflo(smb1.y), bfhi(smb1.y)};
            const f32x4 cv0 = (f32x4){bflo(smc0.x), bfhi(smc0.x), bflo(smc0.y), bfhi(smc0.y)}, cv1 = (f32x4){bflo(smc1.x), bfhi(smc1.x), bflo(smc1.y), bfhi(smc1.y)};
            const f32x4 n0 = sm0 * dAs + bv0 * dtx, n1 = sm1 * dAs + bv1 * dtx;
            float* so = F.out + O_SSMS + smoff; *(GAS f32x4*)so = n0; *(GAS f32x4*)(so + 4) = n1;
            const f32x4 pr = cv0 * n0 + cv1 * n1; const float yp = (pr[0] + pr[1]) + (pr[2] + pr[3]);
            smy = (c & 1) ? smy + yp : yp;
            if (c & 1) { float y = smy; y += dppf<0xB1>(y); y += dppf<0x4E>(y); y += __shfl_xor(y, 4);
                const float yg = (y + F.in[I_DSK][smhd] * xvs) * siluf_(bf2f(PROJ[(size_t)smrow * IN_O_PAD + smhd * 64 + p]));
                float ss = ((tid & 7) == 0) ? yg * yg : 0.f;
                if ((tid & 7) == 0) Y1[(size_t)smrow * MI + smhd * 64 + p] = (bf16)f2bf(yg);
                ss = wave_sum(ss); if (lane == 0) (void)__hip_atomic_fetch_add(SS + (size_t)smrow * 128 + smhd * 4, ss, __ATOMIC_RELAXED, __HIP_MEMORY_SCOPE_AGENT); }
        }
        __syncthreads();
    }
#undef SSD_LOAD
#undef SSD_STAGE
#undef SSD_P2
    if (ih == 0) {
        float* sp = F.out + O_SSMP + ((size_t)(b * 32 + hd) * 64 + 16 * ps + r15) * 128;
#pragma unroll
        for (int stl = 0; stl < 8; ++stl) *(f32x4*)(sp + 16 * stl + 4 * g) = st[stl];
    }
}


__device__ __forceinline__ void mix1_group_arrive(const Ctx& F, int b, int hd) {
    unsigned* cnt = (unsigned*)(F.ws + WS_CTL) + 8192 + 64 * (b * 4 + (hd >> 3));
    asm volatile("s_waitcnt vmcnt(0)" ::: "memory");
    __syncthreads();
    if (F.tid == 0) {
        __builtin_amdgcn_fence(__ATOMIC_RELEASE, "agent"); asm volatile("s_waitcnt vmcnt(0)" ::: "memory");
        (void)__hip_atomic_fetch_add(cnt, 1u, RLX_AGENT); }
}
__device__ __forceinline__ void mix1_group_norm(const Ctx& F, int b, int hd) {
    bf16* Y1 = (bf16*)(F.ws + WS_Y1); const float* SS = (const float*)(F.ws + WS_SS);
    const int g = hd >> 3, part = hd & 7;
    unsigned* cnt = (unsigned*)(F.ws + WS_CTL) + 8192 + 64 * (b * 4 + g);
    if (F.tid == 0) {
        unsigned sp = 0;
        while (__hip_atomic_load(cnt, RLX_AGENT) < 8u) { __builtin_amdgcn_s_sleep(2); if (++sp > (1u << 20)) break; }
        __builtin_amdgcn_fence(__ATOMIC_ACQUIRE, "agent"); asm volatile("s_waitcnt vmcnt(0)" ::: "memory");
    }
    __syncthreads();
    const int row0 = b * SEQ + part * 256 + F.wave * 32;
    for (int r4 = 0; r4 < 32; r4 += 4) {
        v4u y8[4]; float sv[4];
#pragma unroll
        for (int r = 0; r < 4; ++r) { const int row = row0 + r4 + r;
            y8[r] = *(const GAS v4u*)(Y1 + (size_t)row * MI + g * 512 + 8 * F.lane);
            sv[r] = SS[(size_t)(b * 32 + 8 * g + (F.lane & 7)) * SEQ + (row & (SEQ - 1))]; }
#pragma unroll
        for (int r = 0; r < 4; ++r) { const int row = row0 + r4 + r;
            float s = sv[r]; s += dppf<0xB1>(s); s += dppf<0x4E>(s); s += __shfl_xor(s, 4);
            const float rs = frsq_(s * (1.f / 512.f) + EPS); const v4u yy = y8[r];
            *(GAS v4u*)(Y1 + (size_t)row * MI + g * 512 + 8 * F.lane) = (v4u){pk2(bflo(yy.x) * rs, bfhi(yy.x) * rs), pk2(bflo(yy.y) * rs, bfhi(yy.y) * rs), pk2(bflo(yy.z) * rs, bfhi(yy.z) * rs), pk2(bflo(yy.w) * rs, bfhi(yy.w) * rs)}; }
    }
}
__device__ __forceinline__ void mix1_phase(const Ctx& F) {
    constexpr int NU0 = 256, NU1 = ROWS_S * 8;
    if (F.G == NU0 && !SAMPLEFIRST) { mix1_ssd_prompt(F, F.vcu >> 5, F.vcu & 31, F.vcu, NU0); return; }
    if (SAMPLEFIRST && F.G == NU0) {
        const int b = F.vcu >> 5, hd = F.vcu & 31;
        if ((hd >> 3) & 1) { for (int u = F.vcu; u < NU1; u += F.G) mix1_ssd_sample(F, u >> 3, u & 7); mix1_ssd_prompt(F, b, hd); mix1_group_arrive(F, b, hd); }
        else { mix1_ssd_prompt(F, b, hd); mix1_group_arrive(F, b, hd); for (int u = F.vcu; u < NU1; u += F.G) mix1_ssd_sample(F, u >> 3, u & 7); }
        mix1_group_norm(F, b, hd); return; }
    if (SAMPLEFIRST) { for (int u = F.vcu; u < NU1; u += F.G) mix1_ssd_sample(F, u >> 3, u & 7); for (int u = F.vcu; u < NU0; u += F.G) mix1_ssd_prompt(F, u >> 5, u & 31); return; }
    for (int u = F.vcu; u < NU0; u += F.G) mix1_ssd_prompt(F, u >> 5, u & 31);
    for (int u = F.vcu; u < NU1; u += F.G) mix1_ssd_sample(F, u >> 3, u & 7);
}
template <int NR> __device__ __forceinline__ void norm1_rows(const Ctx& F, int rowb) {
    bf16* Y1 = (bf16*)(F.ws + WS_Y1); const float* SS = (const float*)(F.ws + WS_SS); const float* mn = F.in[I_MNORM];
    v4u y8[NR][4]; float sv[NR];
#pragma unroll
    for (int r = 0; r < NR; ++r) { const int row = rowb + r; const GAS v4u* yp = (const GAS v4u*)(Y1 + (size_t)row * MI) + F.lane;
        if (row < ROWS_T) {
#pragma unroll
            for (int i = 0; i < 4; ++i) y8[r][i] = yp[64 * i];
            sv[r] = (F.lane & 1) ? 0.f : SS[(size_t)((row >> 11) * 32 + (F.lane >> 1)) * SEQ + (row & (SEQ - 1))]; }
        else { sv[r] = 0.f;
#pragma unroll
            for (int i = 0; i < 4; ++i) y8[r][i] = (v4u){0u, 0u, 0u, 0u}; } }
#pragma unroll
    for (int r = 0; r < NR; ++r) { const int row = rowb + r; GAS v4u* yp = (GAS v4u*)(Y1 + (size_t)row * MI) + F.lane;
        float s = sv[r];
        s += __shfl_xor(s, 1); s += __shfl_xor(s, 2); s += __shfl_xor(s, 4); s += __shfl_xor(s, 8);
        const float rs = row < ROWS_T ? frsq_(s * (1.f / 512.f) + EPS) : 0.f;
#pragma unroll
        for (int i = 0; i < 4; ++i) {
            const float rr = __shfl(rs, 16 * i); const int c = (i * 64 + F.lane) * 8;
            const f32x4 m0 = *(const f32x4*)(mn + c), m1 = *(const f32x4*)(mn + c + 4); const v4u yy = y8[r][i];
            v4u o;
            o.x = pk2(bflo(yy.x) * rr, bfhi(yy.x) * rr); o.y = pk2(bflo(yy.y) * rr, bfhi(yy.y) * rr);
            o.z = pk2(bflo(yy.z) * rr, bfhi(yy.z) * rr); o.w = pk2(bflo(yy.w) * rr, bfhi(yy.w) * rr);
            yp[64 * i] = o; }
    }
}
__device__ __forceinline__ void norm1_phase(const Ctx& F) {
    const int gw = F.vcu * NWAVES + F.wave, NGW = F.G * NWAVES;
    for (int rowb = gw * 4; rowb < ROWS_P; rowb += NGW * 4) norm1_rows<4>(F, rowb);
}

template <int EPI, int AROWS = 64>
__device__ __forceinline__ void sgemm_run(const Ctx& F, const bf16* A, int lda, const bf16* Bt, int K, int KS, int rb0, int nrb, int cb0, int ncb, int uoff,
                                          bf16* O, int ldc, const float* xin_p, const float* xin_s, float* XRp, const float* gate, const float* rsq = nullptr, const float* cbv = nullptr, int ldcb = 0, int wg0 = 0, int nwg = 0) {
    constexpr int RS = 528, OFF_A = 0, OFF_B = 64 * RS, STAGE = 96 * RS;
    LAS unsigned char* L = F.lds;
    const int tid = F.tid, lane = F.lane, w = F.wave, g = lane >> 4, r15 = lane & 15, rt = w >> 1, ct = w & 1;
    const int lr = tid >> 5, lo = tid & 31;
    const int total = nrb * ncb * KS, klen = K / KS, nch = klen / 256;
    for (int rep = 0; rep < (((REP2 & 32) && KS == 1) ? 2 : 1); ++rep) {
    const int NW = nwg > 0 ? nwg : F.G, li = F.bid - wg0;
    if (li < 0 || li >= NW) continue;
    int u = (NW - 1 - li) - (uoff % NW); if (u < 0) u += NW;
    for (; u < total; u += NW) {
        const int ks = u % KS, t = u / KS, cb = cb0 + t % ncb, rb = rb0 + t / ncb;
        const bf16* ap = A + (size_t)(64 * rb + lr) * lda + ks * klen + 8 * lo;
        const bf16* bp = Bt + (size_t)(32 * cb + lr) * K + ks * klen + 8 * lo;
        v4u a0[4], b0[2];
#pragma unroll
        for (int i = 0; i < AROWS / 16; ++i) a0[i] = *(const GAS v4u*)(ap + (size_t)(16 * i) * lda);
#pragma unroll
        for (int i = 0; i < 2; ++i) b0[i] = *(const GAS v4u*)(bp + (size_t)(16 * i) * K);
        f32x4 acc = (f32x4){0.f, 0.f, 0.f, 0.f};
        for (int c = 0; c < nch; ++c) {
            LAS unsigned char* S = L + (c & 1) * STAGE;
#pragma unroll
            for (int i = 0; i < AROWS / 16; ++i) *(LAS v4u*)(S + OFF_A + (lr + 16 * i) * RS + 16 * lo) = a0[i];
#pragma unroll
            for (int i = 0; i < 2; ++i) *(LAS v4u*)(S + OFF_B + (lr + 16 * i) * RS + 16 * lo) = b0[i];
            if (c + 1 < nch) { ap += 256; bp += 256;
#pragma unroll
                for (int i = 0; i < AROWS / 16; ++i) a0[i] = *(const GAS v4u*)(ap + (size_t)(16 * i) * lda);
#pragma unroll
                for (int i = 0; i < 2; ++i) b0[i] = *(const GAS v4u*)(bp + (size_t)(16 * i) * K); }
            __syncthreads();
            if (16 * rt < AROWS) {
#pragma unroll
            for (int q = 0; q < 8; ++q) {
                const bf16x8 af = *(const LAS bf16x8*)(S + OFF_A + (16 * rt + r15) * RS + (32 * q + 8 * g) * 2), bf = *(const LAS bf16x8*)(S + OFF_B + (16 * ct + r15) * RS + (32 * q + 8 * g) * 2);
                acc = MFMA16(bf, af, acc); } }
        }
        __syncthreads();
        const int token = 64 * rb + 16 * rt + r15, n = 32 * cb + 16 * ct + 4 * g;
        if (EPI == 3) { if (16 * rt < AROWS) *(f32x4*)(XRp + (size_t)token * ldc + n) = acc; }
        else if (EPI == 4) { const float rstd = frsq_(rsq[token] * (1.f / D) + EPS); const f32x4 c4 = *(const f32x4*)(cbv + (size_t)(token >> 11) * ldcb + n); const f32x4 y = acc * rstd + c4;
            *(GAS v2u*)(O + (size_t)token * ldc + n) = (v2u){pk2(y[0], y[1]), pk2(y[2], y[3])}; }
        else if (EPI == 0 || EPI == 1) {
            if (EPI == 1) {
#pragma unroll
                for (int e = 0; e < 4; ++e) { const float r = fmaxf(acc[e], 0.f); acc[e] = r * r; } }
            *(GAS v2u*)(O + (size_t)token * ldc + n) = (v2u){pk2(acc[0], acc[1]), pk2(acc[2], acc[3])};
        } else {
            const f32x4 g4 = *(const f32x4*)(gate + (size_t)pg8::mod_row(token) * MODW + n);
            float* op = XRp + (size_t)token * D + n;
            if (KS == 1) { const float* xr = token < ROWS_P ? xin_p + (size_t)token * D : xin_s + (size_t)(token - ROWS_P) * D; *(f32x4*)op = *(const f32x4*)(xr + n) + g4 * acc; }
            else {
                float gs = 1.f;
                if (rsq) { float sq = 0.f;
#pragma unroll
                    for (int h8 = 0; h8 < 8; ++h8) sq += rsq[(size_t)token * 128 + (8 * ks + h8) * 4];
                    gs = frsq_(sq * (1.f / 512.f) + EPS); }
#pragma unroll
                for (int e = 0; e < 4; ++e) (void)__hip_atomic_fetch_add(op + e, g4[e] * acc[e] * gs, __ATOMIC_RELAXED, __HIP_MEMORY_SCOPE_AGENT); }
        }
    }
    }
}

constexpr int NPHASE = 18;
__global__ void __launch_bounds__(NTHR, 2) mega_fwd(Args args) {
    extern __shared__ __attribute__((aligned(16))) unsigned char lds_raw[];
    Ctx F;
    F.lds = (LAS unsigned char*)lds_raw;
    F.tid = threadIdx.x; F.lane = F.tid & 63; F.wave = __builtin_amdgcn_readfirstlane(F.tid >> 6);
    F.G = gridDim.x; F.bid = blockIdx.x; F.vcu = (F.G % 8 == 0) ? (F.bid % 8) * (F.G / 8) + F.bid / 8 : F.bid;
    F.in = args.in; F.out = args.out; F.ws = args.ws;
    volatile LAS unsigned* MISC = (volatile LAS unsigned*)(F.lds + MISC_OFF);
    for (int u = F.tid; u < (LDS_BYTES - LDSCTL_OFF) / 4; u += NTHR) ((LAS unsigned*)(F.lds + LDSCTL_OFF))[u] = 0u;
    __syncthreads();
    const int lo = args.ph_lo, hi = args.ph_hi;
    XcdBarrier bar; bar.bar = (unsigned*)(F.ws + WS_CTL) + CW_BAR; bar.x = 0; bar.st = nullptr;
    if (hi - lo > 1) bar = xcd_barrier_post((unsigned*)(F.ws + WS_CTL) + CW_BAR, MISC + 8);

    float* mod = (float*)(F.ws + WS_MOD);
    float* XR = (float*)(F.ws + WS_XR);
    float* modL1 = mod + (size_t)NMODROW * MODW;
#define IN(k) (lo <= (k) && (k) < hi)
#define SEAM(k) do { if ((k) + 1 < hi) { xcd_barrier(bar); if (REP2 & 64) xcd_barrier(bar); } } while (0)
#define GEMM_BF16(ACT, Aoff, Boff, Ooff, N_, LDC_, K_, RSi, CBo) do { pg8::Gemm g{(const bf16*)(F.ws + (Aoff)), (const bf16*)(F.ws + (Boff)), ROWS_P, (N_), (K_)}; pg8::StaticOrder S; S.init(ROWS_P, (N_), F.G, F.bid); \
        pg8::EpiBf16<ACT> E{(bf16*)(F.ws + (Ooff)), (LDC_), RSB + (size_t)(RSi) * M_PAD, CBB + (CBo), CB_LD}; pg8::gemm_phase<pg8::EpiBf16<ACT>, pg8::StaticOrder, PG8_ALIGN, PG8_SP2>(F.lds, g, S, E); } while (0)
#define GEMM_RES(XF32, Aoff, Boff, K_, xp_, gate_, XGoff, gnw_, smod_, RSi) do { pg8::Gemm g{(const bf16*)(F.ws + (Aoff)), (const bf16*)(F.ws + (Boff)), ROWS_P, D, (K_)}; pg8::StaticOrder S; S.init(ROWS_P, D, F.G, F.bid); \
        pg8::EpiRes<XF32> E{(const void*)(xp_), XRb, (gate_), (RSi) < 0 ? nullptr : (bf16*)(F.ws + (XGoff)), (gnw_), (smod_), RSB + (size_t)((RSi) < 0 ? 0 : (RSi)) * M_PAD}; pg8::gemm_phase<pg8::EpiRes<XF32>, pg8::StaticOrder, PG8_ALIGN, PG8_SP2>(F.lds, g, S, E); } while (0)
#define SG_BF16(ACT, Aoff, Boff, Ooff, LDC_, K_, rb0_, nrb_, nt0_, nnt_, uoff_) sgemm_run<ACT>(F, (const bf16*)(F.ws + (Aoff)), (K_), (const bf16*)(F.ws + (Boff)), (K_), 1, (rb0_), (nrb_), (nt0_), (nnt_), (uoff_), \
        (bf16*)(F.ws + (Ooff)), (LDC_), nullptr, nullptr, nullptr, nullptr)
#define SG_RES(Aoff, Boff, K_, KS_, xp_, xs_, gate_) sgemm_run<2>(F, (const bf16*)(F.ws + (Aoff)), (K_), (const bf16*)(F.ws + (Boff)), (K_), (KS_), 256, 2, 0, D / 32, 0, nullptr, 0, (xp_), (xs_), XR, (gate_))
#define SG_CB(idx, Boff, ncb_, CBo, uoff_, wg0_, nwg_) sgemm_run<3, 16>(F, (const bf16*)(F.ws + WS_SHB) + (size_t)(idx) * 192 * 1024, 1024, (const bf16*)(F.ws + (Boff)), 1024, 1, 0, 1, 0, (ncb_), (uoff_), nullptr, CB_LD, nullptr, nullptr, CBB + (CBo), nullptr, nullptr, nullptr, 0, (wg0_), (nwg_))
    float* RSB = (float*)(F.ws + WS_RS); float* CBB = (float*)(F.ws + WS_CB);
    float* XRS = XR + (size_t)ROWS_P * D;
    bf16* XRb = (bf16*)XR;
    if (IN(0)) { p0_phase(F); if ((REP_MASK >> 0) & 1) { xcd_barrier(bar); p0_phase(F); } SEAM(0); }
    if (IN(1)) { xg_phase(F, F.in[I_XP], F.in[I_XS], F.in[I_NMIX], mod + 0 * D, mod + 1 * D);
                 SG_CB(0, WS_WIE, IN_E / 32, CB_OFF0, 0, 0, 0); SEAM(1); }
    if (IN(2)) { GEMM_BF16(0, WS_H, WS_WIE, WS_BIG, IN_E, IN_E, D, 0, CB_OFF0); SG_BF16(0, WS_H, WS_WIE, WS_BIG, IN_E, D, 256, 2, 0, IN_E / 32, 0);
                 if (F.G == 256) { SG_CB(1, WS_W1, FF / 32, CB_OFF1, 0, 128, 128); SG_CB(2, WS_WIO, IN_O / 32, CB_OFF2, 128, 128, 128); SG_CB(3, WS_W1 + 8 * MiB, FF / 32, CB_OFF3, 289, 128, 128); }
                 else { SG_CB(1, WS_W1, FF / 32, CB_OFF1, 0, 0, 0); SG_CB(2, WS_WIO, IN_O / 32, CB_OFF2, 128, 0, 0); SG_CB(3, WS_W1 + 8 * MiB, FF / 32, CB_OFF3, 289, 0, 0); } SEAM(2); }
    if (IN(3)) { mix0_phaseA(F); xcd_barrier(bar); mix0_phaseB(F); if ((REP_MASK >> 3) & 1) { xcd_barrier(bar); mix0_phaseA(F); xcd_barrier(bar); mix0_phaseB(F); } SEAM(3); }
    if (IN(4)) { GEMM_RES(true, WS_A2, WS_WOE, D, F.in[I_XP], mod + 2 * D, WS_H, F.in[I_NMLP], mod + 4 * D, 1); SG_RES(WS_A2, WS_WOE, D, 1, F.in[I_XP], F.in[I_XS], mod + 2 * D); SEAM(4); }
    if (IN(6)) { norm_sample_publish(F, WS_H, XRS, F.in[I_NMLP], mod + 3 * D, mod + 4 * D, 0);
                 GEMM_BF16(1, WS_H, WS_W1, WS_BIG, FF, FF, D, 1, CB_OFF1); norm_sample_wait(F, 0); SG_BF16(1, WS_H, WS_W1, WS_BIG, FF, D, 256, 2, 0, FF / 32, 0); SEAM(6); }
    if (IN(7)) { GEMM_RES(false, WS_BIG, WS_W2, FF, XRb, mod + 5 * D, WS_H, F.in[I_NMIX] + D, modL1 + 1 * D, 2); SG_RES(WS_BIG, WS_W2, FF, 4, XR, XRS, mod + 5 * D); SEAM(7); }
    if (IN(9)) { norm_sample_publish(F, WS_H, XRS, F.in[I_NMIX] + D, modL1 + 0 * D, modL1 + 1 * D, 1);
                 GEMM_BF16(0, WS_H, WS_WIO, WS_BIG, 5120, IN_O_PAD, D, 2, CB_OFF2); norm_sample_wait(F, 1); SG_BF16(0, WS_H, WS_WIO, WS_BIG, IN_O_PAD, D, 256, 2, 0, IN_O / 32, 0);
                 sgemm_run<4>(F, (const bf16*)(F.ws + WS_H), D, (const bf16*)(F.ws + WS_WIO), D, 1, 0, 256, 160, 1, 2 * (IN_O / 32), (bf16*)(F.ws + WS_BIG), IN_O_PAD, nullptr, nullptr, nullptr, nullptr, RSB + (size_t)2 * M_PAD, CBB + CB_OFF2, CB_LD); SEAM(9); }
    if (IN(10)) { conv1_phase(F); if ((REP_MASK >> 10) & 1) { xcd_barrier(bar); conv1_phase(F); } SEAM(10); }
    if (IN(11)) { mix1_phase(F); if ((REP_MASK >> 11) & 1) { xcd_barrier(bar); mix1_phase(F); } SEAM(11); }
    if (IN(12) && F.G != 256) { norm1_phase(F); SEAM(12); }
    if (IN(13)) { GEMM_RES(false, WS_Y1, WS_WOO, MI, XRb, modL1 + 2 * D, WS_H3, F.in[I_NMLP] + D, modL1 + 4 * D, 3); sgemm_run<2>(F, (const bf16*)(F.ws + WS_Y1), MI, (const bf16*)(F.ws + WS_WOO), MI, 4, 256, 2, 0, D / 32, 0, nullptr, 0, XR, XRS, XR, modL1 + 2 * D, (const float*)(F.ws + WS_SS)); SEAM(13); }
    if (IN(15)) { norm_sample_publish(F, WS_H3, XRS, F.in[I_NMLP] + D, modL1 + 3 * D, modL1 + 4 * D, 2);
                 GEMM_BF16(1, WS_H3, WS_W1 + 8 * MiB, WS_BIG, FF, FF, D, 3, CB_OFF3); norm_sample_wait(F, 2); SG_BF16(1, WS_H3, WS_W1 + 8 * MiB, WS_BIG, FF, D, 256, 2, 0, FF / 32, 0); SEAM(15); }
    if (IN(16)) { GEMM_RES(false, WS_BIG, WS_W2 + 8 * MiB, FF, XRb, modL1 + 5 * D, WS_H, nullptr, nullptr, -1); SG_RES(WS_BIG, WS_W2 + 8 * MiB, FF, 4, XR, XRS, modL1 + 5 * D); SEAM(16); }
    if (IN(17)) { final_phase(F); }
#undef IN
#undef SEAM
}

extern "C" void kernel_launch(void* const* d_in, const int* in_sizes, int n_in, void* d_out, int out_size, void* d_ws, size_t ws_size, hipStream_t stream) {
    static int grid = 0;
    if (grid == 0) {
        if (n_in != 28 || out_size != (int)O_END || ws_size < WS_END) { fprintf(stderr, "kernel_launch: unexpected shapes: n_in %d out %d ws %zu\n", n_in, out_size, ws_size); grid = -1; return; }
        int dev = 0, cus = 0, per_cu = 0;
        if (hipGetDevice(&dev) != hipSuccess || hipDeviceGetAttribute(&cus, hipDeviceAttributeMultiprocessorCount, dev) != hipSuccess) { grid = -1; return; }
        if (hipFuncSetAttribute((const void*)mega_fwd, hipFuncAttributeMaxDynamicSharedMemorySize, LDS_BYTES) != hipSuccess) { fprintf(stderr, "kernel_launch: hipFuncSetAttribute failed\n"); grid = -1; return; }
        if (hipOccupancyMaxActiveBlocksPerMultiprocessor(&per_cu, (const void*)mega_fwd, NTHR, LDS_BYTES) != hipSuccess || per_cu < 1)
            fprintf(stderr, "kernel_launch: occupancy query reports %d workgroups per CU\n", per_cu);
        (void)hipGetLastError();
        grid = cus;
    }
    if (grid < 0) return;
    (void)hipMemsetAsync((char*)d_ws + WS_CTL, 0, CTL_ZERO_BYTES, stream);
    Args a{};
    for (int i = 0; i < 28; ++i) a.in[i] = (const float*)d_in[i];
    a.out = (float*)d_out; a.ws = (unsigned char*)d_ws;
#if MK_ONE_LAUNCH
    a.ph_lo = 0; a.ph_hi = NPHASE;
    hipLaunchKernelGGL(mega_fwd, dim3(grid), dim3(NTHR), LDS_BYTES, stream, a);
#else
    for (int ph = 0; ph < NPHASE; ++ph) { a.ph_lo = ph; a.ph_hi = ph + 1; hipLaunchKernelGGL(mega_fwd, dim3(grid), dim3(NTHR), LDS_BYTES, stream, a); }
#endif
}
```
